# Optimizing an MI355X kernel written in HIP

```python
import jax, jax.numpy as jnp
from jax import lax
import numpy as np

D_MODEL = 1024
BATCH = 4
SEQ = 4096
DEPTH = 1
DEC_BATCH = 16
DEC_SEQ = 64
PAST_LEN = 1024

CHUNK = 64
HG_HEADS = 8
HG_DK = 128
HG_DV = D_MODEL // HG_HEADS
HG_F = HG_HEADS * HG_DK
HG_V = HG_HEADS * HG_DV
CONV_DIM = 1024
CONV_W = 3
D_FF = ((8 * D_MODEL // 3 + 255) // 256) * 256
PLE_DIM = 256
EPS = 1e-6
IN_SPLITS = (HG_F, 2 * HG_F, 2 * HG_F + HG_V, 2 * HG_F + 2 * HG_V,
             2 * HG_F + 2 * HG_V + CONV_DIM, 2 * HG_F + 2 * HG_V + 2 * CONV_DIM,
             2 * HG_F + 2 * HG_V + 3 * CONV_DIM, 2 * HG_F + 2 * HG_V + 3 * CONV_DIM + D_MODEL)
IN_COLS = 2 * HG_F + 2 * HG_V + 3 * CONV_DIM + 2 * D_MODEL

kernel_name = 'hgrn2_shortconv_gated_stream_step'


def rmsnorm(x, g):
    xf = x.astype(jnp.float32)
    y = xf * lax.rsqrt(jnp.mean(xf * xf, axis=-1, keepdims=True) + EPS)
    return (y * g.astype(jnp.float32)).astype(x.dtype)


def hgrn_block(S, q, k, v, logf):
    c = q.shape[2]
    bcum = jnp.cumsum(logf, axis=2)
    causal = jnp.tril(jnp.ones((c, c), dtype=bool))[None, None, :, :, None]
    diff = bcum[:, :, :, None, :] - bcum[:, :, None, :, :]
    decay = jnp.exp(jnp.where(causal, diff, -jnp.inf))
    scores = jnp.einsum('bhtk,bhtsk,bhsk->bhts', q, decay, k)
    o = (jnp.einsum('bhts,bhsv->bhtv', scores, v)
         + jnp.einsum('bhtk,bhkv->bhtv', q * jnp.exp(bcum), S))
    blast = bcum[:, :, -1:, :]
    S_new = (jnp.exp(blast[:, :, 0, :])[..., None] * S
             + jnp.einsum('bhsk,bhsv->bhkv', k * jnp.exp(blast - bcum), v))
    return S_new, o


def hgrn2(q_raw, f_raw, i_raw, g_raw, lb, S0, g_norm):
    b, t, _ = q_raw.shape
    c = min(CHUNK, t)
    n = t // c

    def blocks(a, d):
        return a.astype(jnp.float32).reshape(b, n, c, HG_HEADS, d).transpose(1, 0, 3, 2, 4)

    fz = f_raw.astype(jnp.float32)
    logf = jnp.log(lb + (1.0 - lb) * jax.nn.sigmoid(fz))
    k = (1.0 - lb) * jax.nn.sigmoid(-fz)
    q = jax.nn.silu(q_raw.astype(jnp.float32)) * HG_DK ** -0.5
    xs = (blocks(q, HG_DK), blocks(k, HG_DK), blocks(i_raw, HG_DV), blocks(logf, HG_DK))

    def step(S, blk):
        return hgrn_block(S, *blk)

    S_fin, o = lax.scan(step, S0.astype(jnp.float32), xs)
    o = o.transpose(1, 0, 3, 2, 4).reshape(b, t, HG_HEADS, HG_DV)
    o = rmsnorm(o, g_norm).reshape(b, t, HG_V)
    return (o * jax.nn.silu(g_raw.astype(jnp.float32))).astype(q_raw.dtype), S_fin


def short_conv(u, buf, w):
    t = u.shape[1]
    full = jnp.concatenate([buf.astype(u.dtype), u], axis=1)
    y = w[0] * full[:, 0:t]
    for j in range(1, CONV_W):
        y = y + w[j] * full[:, j:j + t]
    return y, full[:, t:]


def layer(x, p, S0, buf, lb, norm_mix, w_in, conv_w, hg_norm, w_branch_a, w_branch_b,
          w_out, norm_ffn, w_gate_up, w_down, norm_ple, w_ple, w_ple_gate):
    n = rmsnorm(x, norm_mix)
    z = n @ w_in
    q_raw, f_raw, i_raw, g_raw, b_g, c_g, h_c, za, zb = jnp.split(z, IN_SPLITS, axis=-1)
    o_a, S_new = hgrn2(q_raw, f_raw, i_raw, g_raw, lb, S0, hg_norm)
    conv_out, buf_new = short_conv(c_g * h_c, buf, conv_w)
    o_b = b_g * conv_out
    mix = jax.nn.sigmoid(za) * (o_a @ w_branch_a) + jax.nn.sigmoid(zb) * (o_b @ w_branch_b)
    x = x + mix @ w_out
    gate, up = jnp.split(rmsnorm(x, norm_ffn) @ w_gate_up, 2, axis=-1)
    x = x + (jax.nn.silu(gate) * up) @ w_down
    x = x + jax.nn.sigmoid(rmsnorm(x, norm_ple) @ w_ple_gate) * (p @ w_ple)
    return x, S_new, buf_new


def setup_inputs(seed: int = 0) -> dict:
    key = jax.random.key(seed)
    ks = jax.random.split(key, 21)

    def nrm(k, shape, scale):
        return jax.random.normal(k, shape, jnp.float32) * scale

    return {
        'x_prompt': nrm(ks[0], (BATCH, SEQ, D_MODEL), 1.0),
        'x_sample': nrm(ks[1], (DEC_BATCH, DEC_SEQ, D_MODEL), 1.0),
        'p_prompt': nrm(ks[2], (DEPTH, BATCH, SEQ, PLE_DIM), 1.0),
        'p_sample': nrm(ks[3], (DEPTH, DEC_BATCH, DEC_SEQ, PLE_DIM), 1.0),
        'state_hgrn': nrm(ks[4], (DEPTH, DEC_BATCH, HG_HEADS, HG_DK, HG_DV), 0.5),
        'state_conv': nrm(ks[5], (DEPTH, DEC_BATCH, CONV_W - 1, CONV_DIM), 1.0),
        'lower_bounds': nrm(ks[6], (DEPTH + 1, HG_F), 1.0),
        'norm_mix': 1.0 + nrm(ks[7], (DEPTH, D_MODEL), 0.01),
        'w_in': nrm(ks[8], (DEPTH, D_MODEL, IN_COLS), D_MODEL ** -0.5),
        'conv_w': nrm(ks[9], (DEPTH, CONV_W, CONV_DIM), CONV_W ** -0.5),
        'hg_norm': 1.0 + nrm(ks[10], (DEPTH, HG_DV), 0.01),
        'w_branch_a': nrm(ks[11], (DEPTH, HG_V, D_MODEL), HG_V ** -0.5),
        'w_branch_b': nrm(ks[12], (DEPTH, CONV_DIM, D_MODEL), CONV_DIM ** -0.5),
        'w_out': nrm(ks[13], (DEPTH, D_MODEL, D_MODEL), D_MODEL ** -0.5),
        'norm_ffn': 1.0 + nrm(ks[14], (DEPTH, D_MODEL), 0.01),
        'w_gate_up': nrm(ks[15], (DEPTH, D_MODEL, 2 * D_FF), D_MODEL ** -0.5),
        'w_down': nrm(ks[16], (DEPTH, D_FF, D_MODEL), D_FF ** -0.5),
        'norm_ple': 1.0 + nrm(ks[17], (DEPTH, D_MODEL), 0.01),
        'w_ple': nrm(ks[18], (DEPTH, PLE_DIM, D_MODEL), PLE_DIM ** -0.5),
        'w_ple_gate': nrm(ks[19], (DEPTH, D_MODEL, D_MODEL), D_MODEL ** -0.5),
        'norm_final': 1.0 + nrm(ks[20], (D_MODEL,), 0.01),
    }


def reference(x_prompt, x_sample, p_prompt, p_sample, state_hgrn, state_conv, lower_bounds,
              norm_mix, w_in, conv_w, hg_norm, w_branch_a, w_branch_b, w_out, norm_ffn,
              w_gate_up, w_down, norm_ple, w_ple, w_ple_gate, norm_final):
    lb_all = jnp.cumsum(jax.nn.softmax(lower_bounds.astype(jnp.float32), axis=0), axis=0)
    b = x_prompt.shape[0]
    hp, hs = x_prompt, x_sample
    hgrn_p, conv_p, hgrn_s, conv_s = [], [], [], []
    for l in range(DEPTH):
        w = (lb_all[l], norm_mix[l], w_in[l], conv_w[l], hg_norm[l], w_branch_a[l], w_branch_b[l],
             w_out[l], norm_ffn[l], w_gate_up[l], w_down[l], norm_ple[l], w_ple[l], w_ple_gate[l])
        S0 = jnp.zeros((b, HG_HEADS, HG_DK, HG_DV), jnp.float32)
        buf0 = jnp.zeros((b, CONV_W - 1, CONV_DIM), x_prompt.dtype)
        hp, Sp, cp = layer(hp, p_prompt[l], S0, buf0, *w)
        hs, Ss, cs = layer(hs, p_sample[l], state_hgrn[l], state_conv[l], *w)
        hgrn_p.append(Sp.astype(state_hgrn.dtype))
        conv_p.append(cp.astype(state_conv.dtype))
        hgrn_s.append(Ss.astype(state_hgrn.dtype))
        conv_s.append(cs.astype(state_conv.dtype))
    y_prompt = rmsnorm(hp, norm_final)
    y_sample = rmsnorm(hs, norm_final)
    return (y_prompt, y_sample, jnp.stack(hgrn_p), jnp.stack(conv_p), jnp.stack(hgrn_s), jnp.stack(conv_s))
```

```cpp
#include <hip/hip_runtime.h>
#include <hip/hip_cooperative_groups.h>
#include <cstdio>
namespace cg = cooperative_groups;

#define LAS __attribute__((address_space(3)))
typedef unsigned short bf16_t;
typedef short bf16x8 __attribute__((ext_vector_type(8)));
typedef short s16x4 __attribute__((ext_vector_type(4)));
typedef float f32x4 __attribute__((ext_vector_type(4)));
typedef unsigned u32x4 __attribute__((ext_vector_type(4)));
typedef unsigned u32x2 __attribute__((ext_vector_type(2)));
typedef _Float16 h16x8 __attribute__((ext_vector_type(8)));

constexpr int DM = 1024, MP = 16384, MS = 1024, MT = MP + MS;
constexpr int NIN = 9216, DFF = 2816, PLE = 256;
constexpr int NCHUNK = MT / 64, NITEM = NCHUNK * 8;
constexpr float EPS = 1e-6f;
constexpr size_t A1 = (size_t)MT * DM * 2;

constexpr size_t WS_S0 = 0, WS_S1 = A1, WS_S2 = 2 * A1, WS_S3 = 3 * A1, WS_S4 = 4 * A1, WS_S5 = 5 * A1, WS_S6 = 6 * A1, WS_TAIL = 7 * A1;
constexpr size_t M_RSS = WS_S6;
constexpr size_t M_DK = WS_S6 + 524288;
constexpr size_t M_LB = WS_S6 + 1572864;
constexpr size_t M_BTA = WS_S6 + 2097152, M_BTB = M_BTA + 2097152, M_BTO = M_BTB + 2097152, M_BTPG = M_BTO + 2097152;
constexpr size_t M_BTGU = M_BTPG + 2097152, M_BTD = M_BTGU + (size_t)2 * DFF * DM * 2, M_BTPLE = M_BTD + (size_t)DM * DFF * 2;
static_assert(M_BTPLE + (size_t)DM * PLE * 2 <= WS_TAIL, "misc slot overflow");
constexpr size_t WS_NEED = WS_TAIL + (size_t)NIN * DM * 2;

constexpr size_t O_HP = (size_t)MT * DM, O_CP = O_HP + 4 * 8 * 128 * 128, O_HS = O_CP + 4 * 2 * 1024, O_CS = O_HS + (size_t)16 * 8 * 128 * 128;

constexpr int LDS_BYTES = 155648;

struct Params {
    const float *x_prompt, *x_sample, *p_prompt, *p_sample, *state_hgrn, *state_conv, *lower_bounds, *norm_mix, *w_in, *conv_w, *hg_norm,
        *w_a, *w_b, *w_out, *norm_ffn, *w_gu, *w_down, *norm_ple, *w_ple, *w_pg, *norm_final;
    float* out; unsigned char* ws;
};

__device__ __forceinline__ unsigned pk2(float lo, float hi) { unsigned r; asm("v_cvt_pk_bf16_f32 %0, %1, %2" : "=v"(r) : "v"(lo), "v"(hi)); return r; }
__device__ __forceinline__ float bflo(unsigned u) { return __uint_as_float(u << 16); }
__device__ __forceinline__ float bfhi(unsigned u) { return __uint_as_float(u & 0xffff0000u); }
__device__ __forceinline__ float sigm(float z) { return __builtin_amdgcn_rcpf(1.0f + __expf(-z)); }
__device__ __forceinline__ float wave_sum(float v) {
#pragma unroll
    for (int o = 1; o < 64; o <<= 1) v += __shfl_xor(v, o);
    return v;
}
__device__ __forceinline__ void unpack8(const u32x4 w, float (&f)[8]) {
    f[0] = bflo(w.x); f[1] = bfhi(w.x); f[2] = bflo(w.y); f[3] = bfhi(w.y); f[4] = bflo(w.z); f[5] = bfhi(w.z); f[6] = bflo(w.w); f[7] = bfhi(w.w);
}
__device__ __forceinline__ u32x4 pack8(const float (&f)[8]) { u32x4 w; w.x = pk2(f[0], f[1]); w.y = pk2(f[2], f[3]); w.z = pk2(f[4], f[5]); w.w = pk2(f[6], f[7]); return w; }

constexpr int BM = 256, BK = 64, HALF = 128, HTB = HALF * BK * 2, NXCD = 8, WGM = 8;
__device__ __forceinline__ int lds_byte(int r, int c) { const int st = (r >> 4) * 2 + (c >> 5), rr = r & 15, cc = c & 31, ob = rr * 64 + cc * 2; return st * 1024 + (ob ^ (((ob >> 9) & 1) << 5)); }
__device__ __forceinline__ void stage_rc(int b, int& R, int& C) { const int st = b / 1024, sb = b % 1024, swz = sb ^ (((sb >> 9) & 1) << 5); R = (st >> 1) * 16 + swz / 64; C = (st & 1) * 32 + (swz % 64) / 2; }
__device__ __forceinline__ int perm32(int rho) { const int n = rho >> 4, i = rho & 15; return 8 * (i >> 2) + 4 * n + (i & 3); }

struct Unit { const char* A; const char* B; int pm, pn, part; };

struct SchedTiles {
    const char* A; const char* B; size_t tstep; int nM, nN, pn0, G, c;
    __device__ __forceinline__ bool next(int i, Unit& u) const {
        const int nwg = nM * nN; const long L = (long)i * G + c; if (L >= nwg) return false;
        int wgid = (int)L; { const int q = nwg / NXCD, r = nwg % NXCD, xcd = wgid % NXCD, off = wgid / NXCD; wgid = (xcd < r ? xcd * (q + 1) : r * (q + 1) + (xcd - r) * q) + off; }
        const int nig = WGM * nN, gid = wgid / nig, fm = gid * WGM, gsz = (nM - fm) < WGM ? (nM - fm) : WGM;
        u.pm = fm + ((wgid % nig) % gsz); u.pn = pn0 + (wgid % nig) / gsz; u.part = 1;
        u.A = A + (size_t)u.pm * tstep; u.B = B + (size_t)u.pn * tstep; return true;
    }
};
struct SchedBranch {
    const char *A0, *B0, *A1p, *B1; size_t tstep; int nM, nN, G, c;
    __device__ __forceinline__ bool next(int i, Unit& u) const {
        const int t = (i >> 1) * G + c; if (t >= nM * nN) return false;
        u.part = i & 1; u.pm = t / nN; u.pn = t % nN;
        u.A = (u.part ? A1p : A0) + (size_t)u.pm * tstep; u.B = (u.part ? B1 : B0) + (size_t)u.pn * tstep; return true;
    }
};

typedef f32x4 Acc[2][2][4][2];

template <class Epi, class Sched>
__device__ __forceinline__ void gemm_phase(LAS unsigned char* lds, const int K, const Sched& S, const Epi& E) {
    const int tid = threadIdx.x, wid = __builtin_amdgcn_readfirstlane(tid >> 6), lane = tid & 63, wr = wid >> 2, wc = wid & 3, fr = lane & 15, fq = lane >> 4;
    const int nt = K / BK;
    unsigned voffA[2], voffB[2];
#pragma unroll
    for (int i = 0; i < 2; ++i) { int R, C; stage_rc(tid * 16 + i * 8192, R, C); const int Rb = (R & ~31) + perm32(R & 31);
        voffA[i] = (unsigned)(R * K + C) * 2u; voffB[i] = (unsigned)(Rb * K + C) * 2u; }
    const size_t kstep = (size_t)(BK * 2);
    const size_t hstep = (size_t)HALF * K * 2;
    const unsigned ldsw = (unsigned)wid * 1024u;
    const int aoff = lds_byte(wr * 64 + fr, fq * 8), boff = lds_byte(wc * 32 + fr, fq * 8);
#define PG8_SA(b, h) (((b) * 2 + (h)) * HTB)
#define PG8_SB(b, h) ((4 + (b) * 2 + (h)) * HTB)
#define PG8_STAGE(bufoff, gbase, voff) do { _Pragma("unroll") for (int _i = 0; _i < 2; ++_i) \
        __builtin_amdgcn_global_load_lds((const unsigned*)((const char*)(gbase) + (voff)[_i]), (LAS unsigned*)(lds + (bufoff) + ldsw + _i * 8192), 16, 0, 0); } while (0)
#define PG8_LDA(dst, b, h) do { _Pragma("unroll") for (int m = 0; m < 4; ++m) _Pragma("unroll") for (int k = 0; k < 2; ++k) dst[m][k] = *(const LAS bf16x8*)(lds + PG8_SA(b, h) + aoff + m * 2048 + k * 1024); } while (0)
#define PG8_LDB(dst, b, h) do { _Pragma("unroll") for (int n = 0; n < 2; ++n) _Pragma("unroll") for (int k = 0; k < 2; ++k) dst[n][k] = *(const LAS bf16x8*)(lds + PG8_SB(b, h) + boff + n * 2048 + k * 1024); } while (0)
#define PG8_MMA(ai, bj, At, Bt) do { __builtin_amdgcn_s_setprio(1); _Pragma("unroll") for (int m = 0; m < 4; ++m) _Pragma("unroll") for (int n = 0; n < 2; ++n) _Pragma("unroll") for (int k = 0; k < 2; ++k) \
        acc[ai][bj][m][n] = __builtin_amdgcn_mfma_f32_16x16x32_bf16(Bt[n][k], At[m][k], acc[ai][bj][m][n], 0, 0, 0); __builtin_amdgcn_s_setprio(0); } while (0)
#define PG8_WAIT_V(n) asm volatile("s_waitcnt vmcnt(" #n ")" ::: "memory")
#define PG8_WAIT_L(n) asm volatile("s_waitcnt lgkmcnt(" #n ")" ::: "memory")
#define PG8_BAR __builtin_amdgcn_s_barrier()
#define PG8_SCHED __builtin_amdgcn_sched_barrier(0)
    Unit cur, nxt; int ui = 0;
    if (!S.next(0, cur)) return;
    Acc acc;
#pragma unroll
    for (int a = 0; a < 2; ++a)
#pragma unroll
        for (int b = 0; b < 2; ++b)
#pragma unroll
            for (int m = 0; m < 4; ++m)
#pragma unroll
                for (int n = 0; n < 2; ++n) acc[a][b][m][n] = (f32x4){0.f, 0.f, 0.f, 0.f};
    bf16x8 At[4][2], B0[2][2], B1[2][2];
    const char* cA = cur.A; const char* cB = cur.B;
    PG8_STAGE(PG8_SB(0, 0), cB, voffB); PG8_STAGE(PG8_SA(0, 0), cA, voffA); PG8_STAGE(PG8_SB(0, 1), cB + hstep, voffB); PG8_STAGE(PG8_SA(0, 1), cA + hstep, voffA);
    if (wr == 1) PG8_BAR;
    PG8_WAIT_V(4); PG8_BAR;
    PG8_STAGE(PG8_SB(1, 0), cB + kstep, voffB); PG8_STAGE(PG8_SA(1, 0), cA + kstep, voffA); PG8_STAGE(PG8_SB(1, 1), cB + hstep + kstep, voffB);
    PG8_WAIT_V(6); PG8_BAR;
    for (;;) {
        const bool has_next = S.next(ui + 1, nxt);
        const char* nA = has_next ? nxt.A : cA; const char* nB = has_next ? nxt.B : cB;
        for (int t = 0; t < nt; t += 2) {
            const bool last = (t == nt - 2);
            const char* a1 = cA + (size_t)(t + 1) * kstep;
            const char* a2 = last ? nA : cA + (size_t)(t + 2) * kstep; const char* b2 = last ? nB : cB + (size_t)(t + 2) * kstep;
            const char* a3 = a2 + kstep; const char* b3 = b2 + kstep;
            PG8_LDB(B0, 0, 0); PG8_SCHED; PG8_LDA(At, 0, 0); PG8_STAGE(PG8_SA(1, 1), a1 + hstep, voffA);
            PG8_WAIT_L(8); PG8_BAR; PG8_WAIT_L(0); PG8_MMA(0, 0, At, B0); PG8_BAR; PG8_SCHED;
            PG8_LDB(B1, 0, 1); PG8_STAGE(PG8_SB(0, 0), b2, voffB);
            PG8_BAR; PG8_WAIT_L(0); PG8_MMA(0, 1, At, B1); PG8_BAR;
            PG8_LDA(At, 0, 1); PG8_STAGE(PG8_SA(0, 0), a2, voffA);
            PG8_BAR; PG8_WAIT_L(0); PG8_MMA(1, 0, At, B0); PG8_BAR; PG8_SCHED;
            PG8_STAGE(PG8_SB(0, 1), b2 + hstep, voffB);
            PG8_WAIT_V(6); PG8_BAR; PG8_MMA(1, 1, At, B1); PG8_BAR;
            PG8_LDB(B0, 1, 0); PG8_SCHED; PG8_LDA(At, 1, 0); PG8_STAGE(PG8_SA(0, 1), a2 + hstep, voffA);
            PG8_WAIT_L(8); PG8_BAR; PG8_WAIT_L(0); PG8_MMA(0, 0, At, B0); PG8_BAR; PG8_SCHED;
            PG8_LDB(B1, 1, 1); PG8_STAGE(PG8_SB(1, 0), b3, voffB);
            PG8_BAR; PG8_WAIT_L(0); PG8_MMA(0, 1, At, B1); PG8_BAR;
            PG8_LDA(At, 1, 1); PG8_STAGE(PG8_SA(1, 0), a3, voffA);
            PG8_BAR; PG8_WAIT_L(0); PG8_MMA(1, 0, At, B0); PG8_BAR; PG8_SCHED;
            PG8_STAGE(PG8_SB(1, 1), b3 + hstep, voffB);
            PG8_WAIT_V(6); PG8_BAR; PG8_MMA(1, 1, At, B1); PG8_BAR;
        }
        const bool keep = E(acc, cur, wr, wc, fr, fq);
        if (!has_next) break;
        if (!keep) {
#pragma unroll
            for (int a = 0; a < 2; ++a)
#pragma unroll
                for (int b = 0; b < 2; ++b)
#pragma unroll
                    for (int m = 0; m < 4; ++m)
#pragma unroll
                        for (int n = 0; n < 2; ++n) acc[a][b][m][n] = (f32x4){0.f, 0.f, 0.f, 0.f};
        }
        cur = nxt; cA = nA; cB = nB; ++ui;
    }
    PG8_WAIT_V(0);
    if (wr == 0) PG8_BAR;
    PG8_BAR;
#undef PG8_SA
#undef PG8_SB
#undef PG8_STAGE
#undef PG8_LDA
#undef PG8_LDB
#undef PG8_MMA
#undef PG8_WAIT_V
#undef PG8_WAIT_L
#undef PG8_BAR
#undef PG8_SCHED
}

#define EPI_ROWS for (int ai = 0; ai < 2; ++ai) _Pragma("unroll") for (int m = 0; m < 4; ++m)
#define EPI_ROW (u.pm * 256 + ai * 128 + wr * 64 + m * 16 + fr)
#define EPI_COLT(bj) ((bj) * 128 + wc * 32 + 8 * fq)

struct Epi1 {
    const float* rss0; const float* lbv; unsigned char* ws; unsigned char* outb;
    template <int ACT> __device__ __forceinline__ void body(const Acc& acc, const Unit& u, int wr, int wc, int fr, int fq, unsigned char* base, int scol, float scale) const {
#pragma unroll
        EPI_ROWS { const int row = EPI_ROW; const float rs = rsqrtf(rss0[row] * (1.0f / DM) + EPS);
#pragma unroll
            for (int bj = 0; bj < 2; ++bj) { const int col = scol + EPI_COLT(bj); float v[8];
#pragma unroll
                for (int j = 0; j < 4; ++j) { v[j] = acc[ai][bj][m][0][j] * rs; v[4 + j] = acc[ai][bj][m][1][j] * rs; }
                if (ACT == 0) {
#pragma unroll
                    for (int j = 0; j < 8; ++j) v[j] = v[j] * sigm(v[j]) * scale;
                } else if (ACT == 1) {
                    const f32x4 l0 = *(const f32x4*)(lbv + col), l1 = *(const f32x4*)(lbv + col + 4);
                    const float lb[8] = {l0[0], l0[1], l0[2], l0[3], l1[0], l1[1], l1[2], l1[3]};
                    h16x8 hv;
#pragma unroll
                    for (int j = 0; j < 8; ++j) hv[j] = (_Float16)__logf(lb[j] + (1.0f - lb[j]) * sigm(v[j]));
                    *(h16x8*)(base + ((size_t)row * DM + col) * 2) = hv; continue;
                } else if (ACT == 3) {
#pragma unroll
                    for (int j = 0; j < 8; ++j) v[j] = sigm(v[j]);
                }
                *(u32x4*)(base + ((size_t)row * DM + col) * 2) = pack8(v); } }
    }
    __device__ __forceinline__ bool operator()(Acc& acc, const Unit& u, int wr, int wc, int fr, int fq) const {
        const int sec = u.pn >> 2, scol = (u.pn & 3) * 256;
        unsigned char* base = sec == 0 ? outb : sec == 1 ? ws + WS_S1 : sec == 2 ? ws + WS_S2 : sec == 3 ? outb + A1 : sec == 4 ? ws + WS_S3 : sec == 5 ? ws + WS_S4 : sec == 6 ? ws + WS_S5 : sec == 7 ? ws + WS_S1 : ws + WS_S2;
        if (sec == 0) body<0>(acc, u, wr, wc, fr, fq, base, scol, 0.08838834764831845f);
        else if (sec == 1) body<1>(acc, u, wr, wc, fr, fq, base, scol, 1.f);
        else if (sec == 3) body<0>(acc, u, wr, wc, fr, fq, base, scol, 1.f);
        else if (sec >= 7) body<3>(acc, u, wr, wc, fr, fq, base, scol, 1.f);
        else body<2>(acc, u, wr, wc, fr, fq, base, scol, 1.f);
        return false;
    }
};

struct EpiBr {
    const unsigned char* SA; const unsigned char* SB; unsigned char* MIX;
    __device__ __forceinline__ bool operator()(Acc& acc, const Unit& u, int wr, int wc, int fr, int fq) const {
#pragma unroll
        EPI_ROWS { const int row = EPI_ROW;
#pragma unroll
            for (int bj = 0; bj < 2; ++bj) { const size_t e = ((size_t)row * DM + u.pn * 256 + EPI_COLT(bj)) * 2;
                float sb[8]; unpack8(*(const u32x4*)(SB + e), sb);
                if (u.part == 0) { float sa[8]; unpack8(*(const u32x4*)(SA + e), sa);
#pragma unroll
                    for (int j = 0; j < 4; ++j) { acc[ai][bj][m][0][j] *= sa[j] * __builtin_amdgcn_rcpf(sb[j]); acc[ai][bj][m][1][j] *= sa[4 + j] * __builtin_amdgcn_rcpf(sb[4 + j]); }
                } else { float v[8];
#pragma unroll
                    for (int j = 0; j < 4; ++j) { v[j] = acc[ai][bj][m][0][j] * sb[j]; v[4 + j] = acc[ai][bj][m][1][j] * sb[4 + j]; }
                    *(u32x4*)(MIX + e) = pack8(v); } } }
        return u.part == 0;
    }
};

struct EpiRes {
    const float* xi_p; const float* xi_s; float* xo; unsigned char* xob; float* rss;
    __device__ __forceinline__ bool operator()(Acc& acc, const Unit& u, int wr, int wc, int fr, int fq) const {
#pragma unroll
        EPI_ROWS { const int row = EPI_ROW; float part = 0.f;
            const float* xr = row < MP ? xi_p + (size_t)row * DM : xi_s + (size_t)(row - MP) * DM;
#pragma unroll
            for (int bj = 0; bj < 2; ++bj) { const int col = u.pn * 256 + EPI_COLT(bj);
                const f32x4 x0 = *(const f32x4*)(xr + col), x1 = *(const f32x4*)(xr + col + 4);
                const f32x4 y0 = x0 + acc[ai][bj][m][0], y1 = x1 + acc[ai][bj][m][1];
                *(f32x4*)(xo + (size_t)row * DM + col) = y0; *(f32x4*)(xo + (size_t)row * DM + col + 4) = y1;
                float v[8] = {y0[0], y0[1], y0[2], y0[3], y1[0], y1[1], y1[2], y1[3]};
#pragma unroll
                for (int j = 0; j < 8; ++j) part += v[j] * v[j];
                *(u32x4*)(xob + ((size_t)row * DM + col) * 2) = pack8(v); }
            part += __shfl_xor(part, 16); part += __shfl_xor(part, 32);
            if (fq == 0) atomicAdd(rss + row, part); }
        return false;
    }
};

struct EpiGU {
    const float* rss; unsigned char* H;
    __device__ __forceinline__ bool operator()(Acc& acc, const Unit& u, int wr, int wc, int fr, int fq) const {
#pragma unroll
        EPI_ROWS { const int row = EPI_ROW; const float rs = rsqrtf(rss[row] * (1.0f / DM) + EPS); float v[8];
#pragma unroll
            for (int j = 0; j < 4; ++j) { const float g0 = acc[ai][0][m][0][j] * rs, g1 = acc[ai][0][m][1][j] * rs;
                v[j] = g0 * sigm(g0) * (acc[ai][1][m][0][j] * rs); v[4 + j] = g1 * sigm(g1) * (acc[ai][1][m][1][j] * rs); }
            *(u32x4*)(H + ((size_t)row * DFF + u.pn * 128 + wc * 32 + 8 * fq) * 2) = pack8(v); }
        return false;
    }
};

struct EpiF32 {
    float* C;
    __device__ __forceinline__ bool operator()(Acc& acc, const Unit& u, int wr, int wc, int fr, int fq) const {
#pragma unroll
        EPI_ROWS { const int row = EPI_ROW;
#pragma unroll
            for (int bj = 0; bj < 2; ++bj) { float* d = C + (size_t)row * DM + u.pn * 256 + EPI_COLT(bj); *(f32x4*)d = acc[ai][bj][m][0]; *(f32x4*)(d + 4) = acc[ai][bj][m][1]; } }
        return false;
    }
};

struct EpiPG {
    const float* rss2; const float* x2; float* uo; float* rss3;
    __device__ __forceinline__ bool operator()(Acc& acc, const Unit& u, int wr, int wc, int fr, int fq) const {
#pragma unroll
        EPI_ROWS { const int row = EPI_ROW; const float rs = rsqrtf(rss2[row] * (1.0f / DM) + EPS); float part = 0.f;
#pragma unroll
            for (int bj = 0; bj < 2; ++bj) { const size_t e = (size_t)row * DM + u.pn * 256 + EPI_COLT(bj);
#pragma unroll
                for (int n = 0; n < 2; ++n) { const f32x4 xx = *(const f32x4*)(x2 + e + 4 * n), uu = *(const f32x4*)(uo + e + 4 * n); f32x4 y;
#pragma unroll
                    for (int j = 0; j < 4; ++j) { y[j] = xx[j] + sigm(acc[ai][bj][m][n][j] * rs) * uu[j]; part += y[j] * y[j]; }
                    *(f32x4*)(uo + e + 4 * n) = y; } }
            part += __shfl_xor(part, 16); part += __shfl_xor(part, 32);
            if (fq == 0) atomicAdd(rss3 + row, part); }
        return false;
    }
};

__device__ __forceinline__ void transpose_item(const float* W, int K, int N, int k0, int srccol0, const float* gain, bf16_t* WT, int dstrow0, LAS float* scr, int lane) {
#pragma unroll 8
    for (int i = 0; i < 32; ++i) { const int kk = 2 * i + (lane >> 5); float w = W[(size_t)(k0 + kk) * N + srccol0 + (lane & 31)]; if (gain) w *= gain[k0 + kk]; scr[kk * 33 + (lane & 31)] = w; }
    asm volatile("s_waitcnt lgkmcnt(0)" ::: "memory");
    const int c = lane & 7;
#pragma unroll
    for (int j = 0; j < 4; ++j) { const int n = (lane >> 3) + 8 * j; const LAS float* s = scr + (8 * c) * 33 + n;
        u32x4 o; o.x = pk2(s[0 * 33], s[1 * 33]); o.y = pk2(s[2 * 33], s[3 * 33]); o.z = pk2(s[4 * 33], s[5 * 33]); o.w = pk2(s[6 * 33], s[7 * 33]);
        *(u32x4*)(WT + (size_t)(dstrow0 + n) * K + k0 + 8 * c) = o; }
    asm volatile("s_waitcnt lgkmcnt(0)" ::: "memory");
}

__device__ __forceinline__ void phase_prep(const Params& p, LAS unsigned char* lds) {
    const int tid = threadIdx.x, wave = tid >> 6, lane = tid & 63;
    const int gw = blockIdx.x * 8 + wave, NGW = gridDim.x * 8;
    unsigned char* ws = p.ws;
    float* rss = (float*)(ws + M_RSS);
    for (int row = gw; row < MT; row += NGW) {
        const float* xr = row < MP ? p.x_prompt + (size_t)row * DM : p.x_sample + (size_t)(row - MP) * DM;
        f32x4 v[4]; float s = 0.f;
#pragma unroll
        for (int j = 0; j < 4; ++j) { v[j] = *(const f32x4*)(xr + 4 * lane + 256 * j); s += (v[j][0] * v[j][0] + v[j][1] * v[j][1]) + (v[j][2] * v[j][2] + v[j][3] * v[j][3]); }
        s = wave_sum(s);
        bf16_t* xb = (bf16_t*)(ws + WS_S0) + (size_t)row * DM;
#pragma unroll
        for (int j = 0; j < 4; ++j) { u32x2 o; o.x = pk2(v[j][0], v[j][1]); o.y = pk2(v[j][2], v[j][3]); *(u32x2*)(xb + 4 * lane + 256 * j) = o; }
        if (lane == 0) { rss[row] = s; rss[MT + row] = 0.f; rss[2 * MT + row] = 0.f; rss[3 * MT + row] = 0.f; }
    }
    if (blockIdx.x == 0) { float* lbv = (float*)(ws + M_LB); for (int c = tid; c < 1024; c += 512) lbv[c] = 1.0f / (1.0f + __expf(p.lower_bounds[1024 + c] - p.lower_bounds[c])); }
    LAS float* scr = (LAS float*)(lds + wave * 8448);
    constexpr int I_IN = 16 * (NIN / 32), I_SQ = 16 * 32, I_GU = 16 * (2 * DFF / 32), I_D = (DFF / 64) * 32, I_PLE = (PLE / 64) * 32;
    constexpr int NIT = I_IN + 4 * I_SQ + I_GU + I_D + I_PLE;
    for (int it = gw; it < NIT; it += NGW) {
        int r = it;
        if (r < I_IN) { const int nb = r % (NIN / 32), kb = r / (NIN / 32); transpose_item(p.w_in, DM, NIN, kb * 64, nb * 32, p.norm_mix, (bf16_t*)(ws + WS_TAIL), nb * 32, scr, lane); continue; } r -= I_IN;
        if (r < 4 * I_SQ) { const int w = r / I_SQ, q = r % I_SQ, nb = q % 32, kb = q / 32;
            const float* W = w == 0 ? p.w_a : w == 1 ? p.w_b : w == 2 ? p.w_out : p.w_pg; const float* g = w == 3 ? p.norm_ple : nullptr;
            bf16_t* D = (bf16_t*)(ws + (w == 0 ? M_BTA : w == 1 ? M_BTB : w == 2 ? M_BTO : M_BTPG));
            transpose_item(W, DM, DM, kb * 64, nb * 32, g, D, nb * 32, scr, lane); continue; } r -= 4 * I_SQ;
        if (r < I_GU) { const int nb = r % (2 * DFF / 32), kb = r / (2 * DFF / 32); const int n0 = nb * 32, pn = n0 >> 8, bj = (n0 >> 7) & 1, j0 = n0 & 127;
            transpose_item(p.w_gu, DM, 2 * DFF, kb * 64, bj * DFF + pn * 128 + j0, p.norm_ffn, (bf16_t*)(ws + M_BTGU), n0, scr, lane); continue; } r -= I_GU;
        if (r < I_D) { const int nb = r % 32, kb = r / 32; transpose_item(p.w_down, DFF, DM, kb * 64, nb * 32, nullptr, (bf16_t*)(ws + M_BTD), nb * 32, scr, lane); continue; } r -= I_D;
        { const int nb = r % 32, kb = r / 32; transpose_item(p.w_ple, PLE, DM, kb * 64, nb * 32, nullptr, (bf16_t*)(ws + M_BTPLE), nb * 32, scr, lane); }
    }
}

__device__ __forceinline__ void phase_pconv(const Params& p) {
    const size_t n4 = (size_t)MT * PLE / 4;
    u32x2* dst = (u32x2*)(p.ws + WS_TAIL);
    for (size_t i = (size_t)blockIdx.x * 512 + threadIdx.x; i < n4; i += (size_t)gridDim.x * 512) {
        const size_t e = i * 4; const float* src = e < (size_t)MP * PLE ? p.p_prompt + e : p.p_sample + (e - (size_t)MP * PLE);
        const f32x4 v = *(const f32x4*)src; u32x2 o; o.x = pk2(v[0], v[1]); o.y = pk2(v[2], v[3]); dst[i] = o;
    }
}

__device__ __forceinline__ void phase_conv(const Params& p) {
    unsigned char* ws = p.ws;
    unsigned char* Bg = ws + WS_S3; const unsigned char* Cg = ws + WS_S4; const unsigned char* Hc = ws + WS_S5;
    const int ntask = (MT / 8) * 128;
    for (int task = blockIdx.x * 512 + threadIdx.x; task < ntask; task += gridDim.x * 512) {
        const int run = task >> 7, c0 = (task & 127) * 8, t0 = run * 8;
        const bool prm = t0 < MP; const int tl = prm ? (t0 & 4095) : ((t0 - MP) & 63), T = prm ? 4096 : 64, sq = prm ? (t0 >> 12) : ((t0 - MP) >> 6);
        float w0[8], w1[8], w2[8], u1[8], u2[8];
#pragma unroll
        for (int j = 0; j < 8; ++j) { w0[j] = p.conv_w[c0 + j]; w1[j] = p.conv_w[1024 + c0 + j]; w2[j] = p.conv_w[2048 + c0 + j]; }
        if (tl == 0) {
            if (prm) {
#pragma unroll
                for (int j = 0; j < 8; ++j) { u1[j] = 0.f; u2[j] = 0.f; }
            } else {
#pragma unroll
                for (int j = 0; j < 8; ++j) { u2[j] = p.state_conv[(size_t)(sq * 2 + 0) * 1024 + c0 + j]; u1[j] = p.state_conv[(size_t)(sq * 2 + 1) * 1024 + c0 + j]; }
            }
        } else {
            float a[8], b[8];
            size_t e = ((size_t)(t0 - 1) * DM + c0) * 2; unpack8(*(const u32x4*)(Cg + e), a); unpack8(*(const u32x4*)(Hc + e), b);
#pragma unroll
            for (int j = 0; j < 8; ++j) u1[j] = a[j] * b[j];
            e = ((size_t)(t0 - 2) * DM + c0) * 2; unpack8(*(const u32x4*)(Cg + e), a); unpack8(*(const u32x4*)(Hc + e), b);
#pragma unroll
            for (int j = 0; j < 8; ++j) u2[j] = a[j] * b[j];
        }
#pragma unroll
        for (int r = 0; r < 8; ++r) {
            const size_t e = ((size_t)(t0 + r) * DM + c0) * 2; float a[8], b[8], g[8], u0[8], y[8];
            unpack8(*(const u32x4*)(Cg + e), a); unpack8(*(const u32x4*)(Hc + e), b); unpack8(*(const u32x4*)(Bg + e), g);
#pragma unroll
            for (int j = 0; j < 8; ++j) { u0[j] = a[j] * b[j]; y[j] = g[j] * (w0[j] * u2[j] + w1[j] * u1[j] + w2[j] * u0[j]); u2[j] = u1[j]; u1[j] = u0[j]; }
            *(u32x4*)(Bg + e) = pack8(y);
            const int tt = tl + r;
            if (tt >= T - 2) { float* o = p.out + (prm ? O_CP : O_CS) + (size_t)(sq * 2 + (tt - (T - 2))) * 1024 + c0;
                *(f32x4*)o = (f32x4){u0[0], u0[1], u0[2], u0[3]}; *(f32x4*)(o + 4) = (f32x4){u0[4], u0[5], u0[6], u0[7]}; }
        }
    }
}

constexpr int L_BC = 0;
constexpr int L_QH = 32768;
constexpr int L_QT = L_QH + 17408;
constexpr int L_KH = L_QT + 17408;
constexpr int L_VV = L_KH + 17408;
constexpr int L_PP = L_VV + 17408;
constexpr int L_SM = L_PP + 9216;
constexpr int L_O = L_SM + 3072;
static_assert(L_O + 64 * 132 * 4 <= LDS_BYTES, "LDS");

__device__ __forceinline__ bf16x8 tr_frag(const LAS bf16_t* base, int stride, int s0, int v0, int lane) {
    const int fq = lane >> 4, i = lane & 15, q = i >> 2, pp = i & 3;
    const LAS bf16_t* a = base + (s0 + fq * 8 + q) * stride + v0 + 4 * pp;
    const s16x4 lo = __builtin_amdgcn_ds_read_tr16_b64_v4i16((LAS s16x4*)a);
    const s16x4 hi = __builtin_amdgcn_ds_read_tr16_b64_v4i16((LAS s16x4*)(a + 4 * stride));
    return (bf16x8){lo[0], lo[1], lo[2], lo[3], hi[0], hi[1], hi[2], hi[3]};
}

__device__ __forceinline__ void hg_load(const Params& p, LAS unsigned char* lds, int row0, int h) {
    const int tid = threadIdx.x;
    const unsigned char* LOGF = p.ws + WS_S1; const unsigned char* V = p.ws + WS_S2;
    LAS float* BC = (LAS float*)(lds + L_BC); LAS bf16_t* VV = (LAS bf16_t*)(lds + L_VV);
#pragma unroll
    for (int i = 0; i < 2; ++i) { const int v = tid + 512 * i, t = v >> 4, c8 = (v & 15) * 8; const size_t e = ((size_t)(row0 + t) * DM + h * 128 + c8) * 2;
        const h16x8 lf = *(const h16x8*)(LOGF + e); const u32x4 vv = *(const u32x4*)(V + e);
        *(LAS f32x4*)(BC + t * 128 + c8) = (f32x4){(float)lf[0], (float)lf[1], (float)lf[2], (float)lf[3]};
        *(LAS f32x4*)(BC + t * 128 + c8 + 4) = (f32x4){(float)lf[4], (float)lf[5], (float)lf[6], (float)lf[7]};
        *(LAS u32x4*)(VV + t * 136 + c8) = vv; }
}

__device__ __forceinline__ void phase_U(const Params& p, LAS unsigned char* lds) {
    const int tid = threadIdx.x, wave = tid >> 6, lane = tid & 63, fr = lane & 15, fq = lane >> 4;
    LAS float* BC = (LAS float*)(lds + L_BC); LAS bf16_t* KT = (LAS bf16_t*)(lds + L_KH); LAS bf16_t* VV = (LAS bf16_t*)(lds + L_VV);
    LAS float* segtot = (LAS float*)(lds + L_SM); LAS float* dkv = segtot + 640;
    bf16_t* UT = (bf16_t*)(p.ws + WS_S4); float* DK = (float*)(p.ws + M_DK);
    for (int it = blockIdx.x; it < NITEM; it += gridDim.x) {
        const int ci = it >> 3, h = it & 7, row0 = ci * 64;
        hg_load(p, lds, row0, h);
        __syncthreads();
        const int ch = tid & 127, seg = tid >> 7;
        float kk[16], bl[16]; float run = 0.f;
#pragma unroll
        for (int j = 0; j < 16; ++j) { const float lf = BC[(seg * 16 + j) * 128 + ch]; kk[j] = 1.0f - __expf(lf); run += lf; bl[j] = run; }
        segtot[seg * 128 + ch] = run;
        __syncthreads();
        const float s0 = segtot[ch], s1 = segtot[128 + ch], s2 = segtot[256 + ch], s3 = segtot[384 + ch];
        const float blast = (s0 + s1) + (s2 + s3);
        const float off = seg == 0 ? 0.f : seg == 1 ? s0 : seg == 2 ? s0 + s1 : s0 + s1 + s2;
        float kv[16];
#pragma unroll
        for (int j = 0; j < 16; ++j) kv[j] = kk[j] * __expf(blast - (off + bl[j]));
        u32x4 w0, w1; w0.x = pk2(kv[0], kv[1]); w0.y = pk2(kv[2], kv[3]); w0.z = pk2(kv[4], kv[5]); w0.w = pk2(kv[6], kv[7]);
        w1.x = pk2(kv[8], kv[9]); w1.y = pk2(kv[10], kv[11]); w1.z = pk2(kv[12], kv[13]); w1.w = pk2(kv[14], kv[15]);
        *(LAS u32x4*)(KT + ch * 72 + seg * 16) = w0; *(LAS u32x4*)(KT + ch * 72 + seg * 16 + 8) = w1;
        if (seg == 0) { const float dk = __expf(blast); dkv[ch] = dk; if (ci < 256) DK[(size_t)it * 128 + ch] = dk; }
        __syncthreads();
        const int kb = wave;
        bf16x8 a[2];
#pragma unroll
        for (int ss = 0; ss < 2; ++ss) a[ss] = *(const LAS bf16x8*)(KT + (kb * 16 + fr) * 72 + ss * 32 + fq * 8);
        const int k4 = kb * 16 + fq * 4;
        const f32x4 dk4 = *(const LAS f32x4*)(dkv + k4);
#pragma unroll
        for (int vb = 0; vb < 8; ++vb) {
            f32x4 acc = (f32x4){0.f, 0.f, 0.f, 0.f};
#pragma unroll
            for (int ss = 0; ss < 2; ++ss) { const bf16x8 b = tr_frag(VV, 136, ss * 32, vb * 16, lane); acc = __builtin_amdgcn_mfma_f32_16x16x32_bf16(a[ss], b, acc, 0, 0, 0); }
            const int v = vb * 16 + fr;
            bf16_t* ut = UT + (size_t)it * 16384 + v * 128 + k4;
            if (ci < 256) { u32x2 o; o.x = pk2(acc[0], acc[1]); o.y = pk2(acc[2], acc[3]); *(u32x2*)ut = o; }
            else { const int sb = ci - 256; const size_t sbase = ((size_t)(sb * 8 + h) * 128 + k4) * 128 + v; float s[4];
#pragma unroll
                for (int j = 0; j < 4; ++j) { s[j] = p.state_hgrn[sbase + (size_t)j * 128]; p.out[O_HS + sbase + (size_t)j * 128] = dk4[j] * s[j] + acc[j]; }
                u32x2 o; o.x = pk2(s[0], s[1]); o.y = pk2(s[2], s[3]); *(u32x2*)ut = o; }
        }
        __syncthreads();
    }
}

__device__ __forceinline__ void phase_scan(const Params& p) {
    bf16_t* UT = (bf16_t*)(p.ws + WS_S4); const float* DK = (const float*)(p.ws + M_DK);
    for (int gid = blockIdx.x * 512 + threadIdx.x; gid < 32 * 4096; gid += gridDim.x * 512) {
        const int e4 = gid & 4095, bh = gid >> 12, b = bh >> 3, h = bh & 7, v = e4 >> 5, k4 = (e4 & 31) * 4;
        f32x4 S = (f32x4){0.f, 0.f, 0.f, 0.f};
        for (int c0 = 0; c0 < 64; c0 += 8) {
            u32x2 uu[8]; f32x4 dd[8];
#pragma unroll
            for (int i = 0; i < 8; ++i) { const size_t it = (size_t)((b * 64 + c0 + i) * 8 + h); uu[i] = *(const u32x2*)(UT + it * 16384 + e4 * 4); dd[i] = *(const f32x4*)(DK + it * 128 + k4); }
#pragma unroll
            for (int i = 0; i < 8; ++i) { const size_t it = (size_t)((b * 64 + c0 + i) * 8 + h);
                u32x2 o; o.x = pk2(S[0], S[1]); o.y = pk2(S[2], S[3]); *(u32x2*)(UT + it * 16384 + e4 * 4) = o;
                S[0] = dd[i][0] * S[0] + bflo(uu[i].x); S[1] = dd[i][1] * S[1] + bfhi(uu[i].x); S[2] = dd[i][2] * S[2] + bflo(uu[i].y); S[3] = dd[i][3] * S[3] + bfhi(uu[i].y); }
        }
        float* o = p.out + O_HP + ((size_t)(b * 8 + h) * 128 + k4) * 128 + v;
#pragma unroll
        for (int j = 0; j < 4; ++j) o[(size_t)j * 128] = S[j];
    }
}

__device__ __forceinline__ void phase_O(const Params& p, LAS unsigned char* lds) {
    const int tid = threadIdx.x, wave = tid >> 6, lane = tid & 63, fr = lane & 15, fq = lane >> 4;
    LAS float* BC = (LAS float*)(lds + L_BC); LAS bf16_t* QH = (LAS bf16_t*)(lds + L_QH); LAS bf16_t* QT = (LAS bf16_t*)(lds + L_QT);
    LAS bf16_t* KH = (LAS bf16_t*)(lds + L_KH); LAS bf16_t* VV = (LAS bf16_t*)(lds + L_VV); LAS bf16_t* PP = (LAS bf16_t*)(lds + L_PP);
    LAS float* segtot = (LAS float*)(lds + L_SM); LAS float* rvec = segtot + 512; LAS float* OO = (LAS float*)(lds + L_O);
    const bf16_t* ST = (const bf16_t*)(p.ws + WS_S4);
    unsigned char* Q = (unsigned char*)p.out; const unsigned char* G = (const unsigned char*)p.out + A1;
    for (int it = blockIdx.x; it < NITEM; it += gridDim.x) {
        const int ci = it >> 3, h = it & 7, row0 = ci * 64;
        hg_load(p, lds, row0, h);
        __syncthreads();
        { const int ch = tid & 127, seg = tid >> 7;
            float kk[16], bl[16]; float run = 0.f;
#pragma unroll
            for (int j = 0; j < 16; ++j) { const float lf = BC[(seg * 16 + j) * 128 + ch]; kk[j] = 1.0f - __expf(lf); run += lf; bl[j] = run; }
            segtot[seg * 128 + ch] = run;
            __syncthreads();
            const float s0 = segtot[ch], s1 = segtot[128 + ch], s2 = segtot[256 + ch];
            const float r = s0 + s1;
            const float off = seg == 0 ? 0.f : seg == 1 ? s0 : seg == 2 ? s0 + s1 : s0 + s1 + s2;
#pragma unroll
            for (int j = 0; j < 16; ++j) { const float bc = off + bl[j]; const int t = seg * 16 + j; BC[t * 128 + ch] = bc;
                const float kv = kk[j] * __expf(fminf(r - bc, 80.f)); KH[t * 136 + ch] = (bf16_t)(pk2(kv, 0.f) & 0xffffu); }
            if (seg == 0) rvec[ch] = r;
        }
        __syncthreads();
#pragma unroll
        for (int i = 0; i < 2; ++i) { const int v = tid + 512 * i, t = v >> 4, c8 = (v & 15) * 8; float q[8], qh[8], qt[8];
            unpack8(*(const u32x4*)(Q + ((size_t)(row0 + t) * DM + h * 128 + c8) * 2), q);
#pragma unroll
            for (int j = 0; j < 8; ++j) { const float bc = BC[t * 128 + c8 + j]; qh[j] = q[j] * __expf(fmaxf(bc - rvec[c8 + j], -80.f)); qt[j] = q[j] * __expf(bc); }
            *(LAS u32x4*)(QH + t * 136 + c8) = pack8(qh); *(LAS u32x4*)(QT + t * 136 + c8) = pack8(qt); }
        __syncthreads();
        const int tb = wave >> 1;
#pragma unroll
        for (int sbi = 0; sbi < 2; ++sbi) { const int sb = (wave & 1) * 2 + sbi; f32x4 acc = (f32x4){0.f, 0.f, 0.f, 0.f};
            if (sb <= tb) {
#pragma unroll
                for (int k = 0; k < 4; ++k) { const bf16x8 a = *(const LAS bf16x8*)(QH + (tb * 16 + fr) * 136 + k * 32 + fq * 8), b = *(const LAS bf16x8*)(KH + (sb * 16 + fr) * 136 + k * 32 + fq * 8);
                    acc = __builtin_amdgcn_mfma_f32_16x16x32_bf16(b, a, acc, 0, 0, 0); }
#pragma unroll
                for (int j = 0; j < 4; ++j) acc[j] = (sb * 16 + fq * 4 + j <= tb * 16 + fr) ? acc[j] : 0.f;
            }
            u32x2 o; o.x = pk2(acc[0], acc[1]); o.y = pk2(acc[2], acc[3]); *(LAS u32x2*)(PP + (tb * 16 + fr) * 72 + sb * 16 + fq * 4) = o; }
        __syncthreads();
        { bf16x8 pa[2], qa[4];
#pragma unroll
            for (int ss = 0; ss < 2; ++ss) pa[ss] = *(const LAS bf16x8*)(PP + (tb * 16 + fr) * 72 + ss * 32 + fq * 8);
#pragma unroll
            for (int k = 0; k < 4; ++k) qa[k] = *(const LAS bf16x8*)(QT + (tb * 16 + fr) * 136 + k * 32 + fq * 8);
#pragma unroll
            for (int vi = 0; vi < 4; ++vi) { const int vb = (wave & 1) * 4 + vi; f32x4 acc = (f32x4){0.f, 0.f, 0.f, 0.f};
                bf16x8 sf[4];
#pragma unroll
                for (int k = 0; k < 4; ++k) sf[k] = *(const bf16x8*)(ST + (size_t)it * 16384 + (vb * 16 + fr) * 128 + k * 32 + fq * 8);
#pragma unroll
                for (int ss = 0; ss < 2; ++ss) { const bf16x8 vf = tr_frag(VV, 136, ss * 32, vb * 16, lane); acc = __builtin_amdgcn_mfma_f32_16x16x32_bf16(vf, pa[ss], acc, 0, 0, 0); }
#pragma unroll
                for (int k = 0; k < 4; ++k) acc = __builtin_amdgcn_mfma_f32_16x16x32_bf16(sf[k], qa[k], acc, 0, 0, 0);
                *(LAS f32x4*)(OO + (tb * 16 + fr) * 132 + vb * 16 + fq * 4) = acc; }
        }
        __syncthreads();
        { const int t = tid >> 3, part = tid & 7; float o[16]; float ss = 0.f;
#pragma unroll
            for (int j = 0; j < 4; ++j) { const f32x4 x = *(const LAS f32x4*)(OO + t * 132 + part * 16 + 4 * j); o[4 * j] = x[0]; o[4 * j + 1] = x[1]; o[4 * j + 2] = x[2]; o[4 * j + 3] = x[3]; ss += (x[0] * x[0] + x[1] * x[1]) + (x[2] * x[2] + x[3] * x[3]); }
            ss += __shfl_xor(ss, 1); ss += __shfl_xor(ss, 2); ss += __shfl_xor(ss, 4);
            const float rstd = rsqrtf(ss * (1.0f / 128.f) + EPS);
            const size_t e = ((size_t)(row0 + t) * DM + h * 128 + part * 16) * 2;
#pragma unroll
            for (int hh = 0; hh < 2; ++hh) { float g[8], y[8]; unpack8(*(const u32x4*)(G + e + hh * 16), g);
#pragma unroll
                for (int j = 0; j < 8; ++j) y[j] = o[hh * 8 + j] * rstd * p.hg_norm[part * 16 + hh * 8 + j] * g[j];
                *(u32x4*)(Q + e + hh * 16) = pack8(y); }
        }
        __syncthreads();
    }
}

__device__ __forceinline__ void phase_final(const Params& p) {
    const int wave = threadIdx.x >> 6, lane = threadIdx.x & 63; const float* rss3 = (const float*)(p.ws + M_RSS) + 3 * MT;
    for (int row = blockIdx.x * 8 + wave; row < MT; row += gridDim.x * 8) {
        const float rs = rsqrtf(rss3[row] * (1.0f / DM) + EPS); float* y = p.out + (size_t)row * DM;
#pragma unroll
        for (int j = 0; j < 4; ++j) { f32x4 v = *(f32x4*)(y + 4 * lane + 256 * j); const f32x4 g = *(const f32x4*)(p.norm_final + 4 * lane + 256 * j);
            v[0] *= rs * g[0]; v[1] *= rs * g[1]; v[2] *= rs * g[2]; v[3] *= rs * g[3]; *(f32x4*)(y + 4 * lane + 256 * j) = v; }
    }
}

__global__ void __launch_bounds__(512, 2) hgrn2_shortconv_fwd(Params p) {
    extern __shared__ __attribute__((aligned(16))) unsigned char smem[];
    LAS unsigned char* lds = (LAS unsigned char*)smem;
    cg::grid_group grid = cg::this_grid();
    unsigned char* ws = p.ws; unsigned char* outb = (unsigned char*)p.out;
    float* rss = (float*)(ws + M_RSS);
    const int G = gridDim.x, c = blockIdx.x;
    const size_t ts1024 = (size_t)256 * 1024 * 2;

    phase_prep(p, lds);
    grid.sync();
    {
        SchedTiles S{(const char*)(ws + WS_S0), (const char*)(ws + WS_TAIL), ts1024, MT / 256, 28, 0, G, c};
        Epi1 E{rss, (const float*)(ws + M_LB), ws, outb};
        gemm_phase(lds, 1024, S, E);
    }
    grid.sync();
    phase_conv(p);
    grid.sync();
    phase_U(p, lds);
    grid.sync();
    phase_scan(p);
    grid.sync();
    phase_O(p, lds);
    grid.sync();
    {
        SchedTiles S{(const char*)(ws + WS_S0), (const char*)(ws + WS_TAIL), ts1024, MT / 256, 8, 28, G, c};
        Epi1 E{rss, (const float*)(ws + M_LB), ws, outb};
        gemm_phase(lds, 1024, S, E);
    }
    grid.sync();
    phase_pconv(p);
    {
        SchedBranch S{(const char*)outb, (const char*)(ws + M_BTA), (const char*)(ws + WS_S3), (const char*)(ws + M_BTB), ts1024, MT / 256, 4, G, c};
        EpiBr E{ws + WS_S1, ws + WS_S2, ws + WS_S5};
        gemm_phase(lds, 1024, S, E);
    }
    grid.sync();
    {
        SchedTiles S{(const char*)(ws + WS_S5), (const char*)(ws + M_BTO), ts1024, MT / 256, 4, 0, G, c};
        EpiRes E{p.x_prompt, p.x_sample, (float*)(ws + WS_S0), ws + WS_S2, rss + MT};
        gemm_phase(lds, 1024, S, E);
    }
    grid.sync();
    {
        SchedTiles S{(const char*)(ws + WS_S2), (const char*)(ws + M_BTGU), ts1024, MT / 256, 22, 0, G, c};
        EpiGU E{rss + MT, ws + WS_S3};
        gemm_phase(lds, 1024, S, E);
    }
    grid.sync();
    {
        SchedTiles S{(const char*)(ws + WS_S3), (const char*)(ws + M_BTD), (size_t)256 * DFF * 2, MT / 256, 4, 0, G, c};
        EpiRes E{(const float*)(ws + WS_S0), (const float*)(ws + WS_S0) + (size_t)MP * DM, (float*)(ws + WS_S0), ws + WS_S2, rss + 2 * MT};
        gemm_phase(lds, DFF, S, E);
    }
    {
        SchedTiles S{(const char*)(ws + WS_TAIL), (const char*)(ws + M_BTPLE), (size_t)256 * PLE * 2, MT / 256, 4, 0, G, c};
        EpiF32 E{p.out};
        gemm_phase(lds, PLE, S, E);
    }
    grid.sync();
    {
        SchedTiles S{(const char*)(ws + WS_S2), (const char*)(ws + M_BTPG), ts1024, MT / 256, 4, 0, G, c};
        EpiPG E{rss + 2 * MT, (const float*)(ws + WS_S0), p.out, rss + 3 * MT};
        gemm_phase(lds, 1024, S, E);
    }
    grid.sync();
    phase_final(p);
}

extern "C" void kernel_launch(void* const* d_in, const int* in_sizes, int n_in, void* d_out, int out_size, void* d_ws, size_t ws_size, hipStream_t stream) {
    static int grid_blocks = 0;
    if (grid_blocks == 0) {
        if (n_in != 21 || ws_size < WS_NEED) { fprintf(stderr, "kernel_launch: unexpected n_in %d / ws_size %zu (need %zu)\n", n_in, ws_size, (size_t)WS_NEED); grid_blocks = -1; return; }
        int dev = 0, cus = 0, per_cu = 0;
        hipGetDevice(&dev);
        hipDeviceGetAttribute(&cus, hipDeviceAttributeMultiprocessorCount, dev);
        if (hipFuncSetAttribute((const void*)hgrn2_shortconv_fwd, hipFuncAttributeMaxDynamicSharedMemorySize, LDS_BYTES) != hipSuccess) { fprintf(stderr, "kernel_launch: hipFuncSetAttribute failed\n"); grid_blocks = -1; return; }
        if (hipOccupancyMaxActiveBlocksPerMultiprocessor(&per_cu, (const void*)hgrn2_shortconv_fwd, 512, LDS_BYTES) != hipSuccess || per_cu < 1) { fprintf(stderr, "kernel_launch: occupancy query gave %d\n", per_cu); per_cu = 1; }
        (void)hipGetLastError();
        grid_blocks = cus * per_cu;
    }
    if (grid_blocks < 0) return;
    Params p{};
    const float** f = (const float**)&p;
    for (int i = 0; i < 21; ++i) f[i] = (const float*)d_in[i];
    p.out = (float*)d_out; p.ws = (unsigned char*)d_ws;
    void* args[] = {&p};
    hipError_t e = hipLaunchCooperativeKernel((const void*)hgrn2_shortconv_fwd, dim3(grid_blocks), dim3(512), args, LDS_BYTES, stream);
    if (e != hipSuccess) fprintf(stderr, "cooperative launch failed: %s (grid %d)\n", hipGetErrorString(e), grid_blocks);
}
```

```cpp
#include <hip/hip_runtime.h>
#include <hip/hip_cooperative_groups.h>
#include <cstdio>
namespace cg = cooperative_groups;

#define LAS __attribute__((address_space(3)))
typedef unsigned short bf16_t;
typedef short bf16x8 __attribute__((ext_vector_type(8)));
typedef short s16x4 __attribute__((ext_vector_type(4)));
typedef float f32x4 __attribute__((ext_vector_type(4)));
typedef unsigned u32x4 __attribute__((ext_vector_type(4)));
typedef unsigned u32x2 __attribute__((ext_vector_type(2)));
typedef _Float16 h16x8 __attribute__((ext_vector_type(8)));

constexpr int DM = 1024, MP = 16384, MS = 1024, MT = MP + MS;
constexpr int NIN = 9216, DFF = 2816, PLE = 256;
constexpr int NCHUNK = MT / 64, NITEM = NCHUNK * 8;
constexpr float EPS = 1e-6f;
constexpr size_t A1 = (size_t)MT * DM * 2;

constexpr size_t WS_S0 = 0, WS_S1 = A1, WS_S2 = 2 * A1, WS_S3 = 3 * A1, WS_S4 = 4 * A1, WS_S5 = 5 * A1, WS_S6 = 6 * A1, WS_TAIL = 7 * A1;
constexpr size_t M_RSS = WS_S6;
constexpr size_t M_DK = WS_S6 + 524288;
constexpr size_t M_LB = WS_S6 + 1572864;
constexpr size_t M_BTA = WS_S6 + 2097152, M_BTB = M_BTA + 2097152, M_BTO = M_BTB + 2097152, M_BTPG = M_BTO + 2097152;
constexpr size_t M_BTGU = M_BTPG + 2097152, M_BTD = M_BTGU + (size_t)2 * DFF * DM * 2, M_BTPLE = M_BTD + (size_t)DM * DFF * 2;
constexpr size_t M_BAR = M_BTPLE + (size_t)DM * PLE * 2;
static_assert(M_BAR + 16384 <= WS_TAIL, "misc slot overflow");
constexpr size_t WS_NEED = WS_TAIL + (size_t)NIN * DM * 2;

constexpr size_t O_HP = (size_t)MT * DM, O_CP = O_HP + 4 * 8 * 128 * 128, O_HS = O_CP + 4 * 2 * 1024, O_CS = O_HS + (size_t)16 * 8 * 128 * 128;

constexpr int LDS_BYTES = 155648;

struct Params {
    const float *x_prompt, *x_sample, *p_prompt, *p_sample, *state_hgrn, *state_conv, *lower_bounds, *norm_mix, *w_in, *conv_w, *hg_norm,
        *w_a, *w_b, *w_out, *norm_ffn, *w_gu, *w_down, *norm_ple, *w_ple, *w_pg, *norm_final;
    float* out; unsigned char* ws;
};

__device__ __forceinline__ unsigned pk2(float lo, float hi) { unsigned r; asm("v_cvt_pk_bf16_f32 %0, %1, %2" : "=v"(r) : "v"(lo), "v"(hi)); return r; }
__device__ __forceinline__ float bflo(unsigned u) { return __uint_as_float(u << 16); }
__device__ __forceinline__ float bfhi(unsigned u) { return __uint_as_float(u & 0xffff0000u); }
__device__ __forceinline__ float sigm(float z) { return __builtin_amdgcn_rcpf(1.0f + __expf(-z)); }
__device__ __forceinline__ float wave_sum(float v) {
#pragma unroll
    for (int o = 1; o < 64; o <<= 1) v += __shfl_xor(v, o);
    return v;
}
__device__ __forceinline__ void unpack8(const u32x4 w, float (&f)[8]) {
    f[0] = bflo(w.x); f[1] = bfhi(w.x); f[2] = bflo(w.y); f[3] = bfhi(w.y); f[4] = bflo(w.z); f[5] = bfhi(w.z); f[6] = bflo(w.w); f[7] = bfhi(w.w);
}
__device__ __forceinline__ u32x4 pack8(const float (&f)[8]) { u32x4 w; w.x = pk2(f[0], f[1]); w.y = pk2(f[2], f[3]); w.z = pk2(f[4], f[5]); w.w = pk2(f[6], f[7]); return w; }

constexpr int BM = 256, BK = 64, HALF = 128, HTB = HALF * BK * 2, NXCD = 8, WGM = 8;
__device__ __forceinline__ int lds_byte(int r, int c) { const int st = (r >> 4) * 2 + (c >> 5), rr = r & 15, cc = c & 31, ob = rr * 64 + cc * 2; return st * 1024 + (ob ^ (((ob >> 9) & 1) << 5)); }
__device__ __forceinline__ void stage_rc(int b, int& R, int& C) { const int st = b / 1024, sb = b % 1024, swz = sb ^ (((sb >> 9) & 1) << 5); R = (st >> 1) * 16 + swz / 64; C = (st & 1) * 32 + (swz % 64) / 2; }
__device__ __forceinline__ int perm32(int rho) { const int n = rho >> 4, i = rho & 15; return 8 * (i >> 2) + 4 * n + (i & 3); }

struct Unit { const char* A; const char* B; int pm, pn, part; };

struct SchedTiles {
    const char* A; const char* B; size_t tstep; int nM, nN, pn0, G, c;
    __device__ __forceinline__ bool next(int i, Unit& u) const {
        const int nwg = nM * nN; const long L = (long)i * G + c; if (L >= nwg) return false;
        int wgid = (int)L; { const int q = nwg / NXCD, r = nwg % NXCD, xcd = wgid % NXCD, off = wgid / NXCD; wgid = (xcd < r ? xcd * (q + 1) : r * (q + 1) + (xcd - r) * q) + off; }
        const int nig = WGM * nN, gid = wgid / nig, fm = gid * WGM, gsz = (nM - fm) < WGM ? (nM - fm) : WGM;
        u.pm = fm + ((wgid % nig) % gsz); u.pn = pn0 + (wgid % nig) / gsz; u.part = 1;
        u.A = A + (size_t)u.pm * tstep; u.B = B + (size_t)u.pn * tstep; return true;
    }
};
struct SchedBranch {
    const char *A0, *B0, *A1p, *B1; size_t tstep; int nM, nN, G, c;
    __device__ __forceinline__ bool next(int i, Unit& u) const {
        const int t = (i >> 1) * G + c; if (t >= nM * nN) return false;
        u.part = i & 1; u.pm = t / nN; u.pn = t % nN;
        u.A = (u.part ? A1p : A0) + (size_t)u.pm * tstep; u.B = (u.part ? B1 : B0) + (size_t)u.pn * tstep; return true;
    }
};

typedef f32x4 Acc[2][2][4][2];

template <class Epi, class Sched>
__device__ __forceinline__ void gemm_phase(LAS unsigned char* lds, const int K, const Sched& S, const Epi& E) {
    const int tid = threadIdx.x, wid = __builtin_amdgcn_readfirstlane(tid >> 6), lane = tid & 63, wr = wid >> 2, wc = wid & 3, fr = lane & 15, fq = lane >> 4;
    const int nt = K / BK;
    unsigned voffA[2], voffB[2];
#pragma unroll
    for (int i = 0; i < 2; ++i) { int R, C; stage_rc(tid * 16 + i * 8192, R, C); const int Rb = (R & ~31) + perm32(R & 31);
        voffA[i] = (unsigned)(R * K + C) * 2u; voffB[i] = (unsigned)(Rb * K + C) * 2u; }
    const size_t kstep = (size_t)(BK * 2);
    const size_t hstep = (size_t)HALF * K * 2;
    const unsigned ldsw = (unsigned)wid * 1024u;
    const int aoff = lds_byte(wr * 64 + fr, fq * 8), boff = lds_byte(wc * 32 + fr, fq * 8);
#define PG8_SA(b, h) (((b) * 2 + (h)) * HTB)
#define PG8_SB(b, h) ((4 + (b) * 2 + (h)) * HTB)
#define PG8_STAGE(bufoff, gbase, voff) do { _Pragma("unroll") for (int _i = 0; _i < 2; ++_i) \
        __builtin_amdgcn_global_load_lds((const unsigned*)((const char*)(gbase) + (voff)[_i]), (LAS unsigned*)(lds + (bufoff) + ldsw + _i * 8192), 16, 0, 0); } while (0)
#define PG8_LDA(dst, b, h) do { _Pragma("unroll") for (int m = 0; m < 4; ++m) _Pragma("unroll") for (int k = 0; k < 2; ++k) dst[m][k] = *(const LAS bf16x8*)(lds + PG8_SA(b, h) + aoff + m * 2048 + k * 1024); } while (0)
#define PG8_LDB(dst, b, h) do { _Pragma("unroll") for (int n = 0; n < 2; ++n) _Pragma("unroll") for (int k = 0; k < 2; ++k) dst[n][k] = *(const LAS bf16x8*)(lds + PG8_SB(b, h) + boff + n * 2048 + k * 1024); } while (0)
#define PG8_MMA(ai, bj, At, Bt) do { __builtin_amdgcn_s_setprio(1); _Pragma("unroll") for (int m = 0; m < 4; ++m) _Pragma("unroll") for (int n = 0; n < 2; ++n) _Pragma("unroll") for (int k = 0; k < 2; ++k) \
        acc[ai][bj][m][n] = __builtin_amdgcn_mfma_f32_16x16x32_bf16(Bt[n][k], At[m][k], acc[ai][bj][m][n], 0, 0, 0); __builtin_amdgcn_s_setprio(0); } while (0)
#define PG8_WAIT_V(n) asm volatile("s_waitcnt vmcnt(" #n ")" ::: "memory")
#define PG8_WAIT_L(n) asm volatile("s_waitcnt lgkmcnt(" #n ")" ::: "memory")
#define PG8_BAR __builtin_amdgcn_s_barrier()
#define PG8_SCHED __builtin_amdgcn_sched_barrier(0)
    Unit cur, nxt; int ui = 0;
    if (!S.next(0, cur)) return;
    Acc acc;
#pragma unroll
    for (int a = 0; a < 2; ++a)
#pragma unroll
        for (int b = 0; b < 2; ++b)
#pragma unroll
            for (int m = 0; m < 4; ++m)
#pragma unroll
                for (int n = 0; n < 2; ++n) acc[a][b][m][n] = (f32x4){0.f, 0.f, 0.f, 0.f};
    bf16x8 At[4][2], B0[2][2], B1[2][2];
    const char* cA = cur.A; const char* cB = cur.B;
    PG8_STAGE(PG8_SB(0, 0), cB, voffB); PG8_STAGE(PG8_SA(0, 0), cA, voffA); PG8_STAGE(PG8_SB(0, 1), cB + hstep, voffB); PG8_STAGE(PG8_SA(0, 1), cA + hstep, voffA);
    if (wr == 1) PG8_BAR;
    PG8_WAIT_V(4); PG8_BAR;
    PG8_STAGE(PG8_SB(1, 0), cB + kstep, voffB); PG8_STAGE(PG8_SA(1, 0), cA + kstep, voffA); PG8_STAGE(PG8_SB(1, 1), cB + hstep + kstep, voffB);
    PG8_WAIT_V(6); PG8_BAR;
    for (;;) {
        const bool has_next = S.next(ui + 1, nxt);
        const char* nA = has_next ? nxt.A : cA; const char* nB = has_next ? nxt.B : cB;
        for (int t = 0; t < nt; t += 2) {
            const bool last = (t == nt - 2);
            const char* a1 = cA + (size_t)(t + 1) * kstep;
            const char* a2 = last ? nA : cA + (size_t)(t + 2) * kstep; const char* b2 = last ? nB : cB + (size_t)(t + 2) * kstep;
            const char* a3 = a2 + kstep; const char* b3 = b2 + kstep;
            PG8_LDB(B0, 0, 0); PG8_SCHED; PG8_LDA(At, 0, 0); PG8_STAGE(PG8_SA(1, 1), a1 + hstep, voffA);
            PG8_WAIT_L(8); PG8_BAR; PG8_WAIT_L(0); PG8_MMA(0, 0, At, B0); PG8_BAR; PG8_SCHED;
            PG8_LDB(B1, 0, 1); PG8_STAGE(PG8_SB(0, 0), b2, voffB);
            PG8_BAR; PG8_WAIT_L(0); PG8_MMA(0, 1, At, B1); PG8_BAR;
            PG8_LDA(At, 0, 1); PG8_STAGE(PG8_SA(0, 0), a2, voffA);
            PG8_BAR; PG8_WAIT_L(0); PG8_MMA(1, 0, At, B0); PG8_BAR; PG8_SCHED;
            PG8_STAGE(PG8_SB(0, 1), b2 + hstep, voffB);
            PG8_WAIT_V(6); PG8_BAR; PG8_MMA(1, 1, At, B1); PG8_BAR;
            PG8_LDB(B0, 1, 0); PG8_SCHED; PG8_LDA(At, 1, 0); PG8_STAGE(PG8_SA(0, 1), a2 + hstep, voffA);
            PG8_WAIT_L(8); PG8_BAR; PG8_WAIT_L(0); PG8_MMA(0, 0, At, B0); PG8_BAR; PG8_SCHED;
            PG8_LDB(B1, 1, 1); PG8_STAGE(PG8_SB(1, 0), b3, voffB);
            PG8_BAR; PG8_WAIT_L(0); PG8_MMA(0, 1, At, B1); PG8_BAR;
            PG8_LDA(At, 1, 1); PG8_STAGE(PG8_SA(1, 0), a3, voffA);
            PG8_BAR; PG8_WAIT_L(0); PG8_MMA(1, 0, At, B0); PG8_BAR; PG8_SCHED;
            PG8_STAGE(PG8_SB(1, 1), b3 + hstep, voffB);
            PG8_WAIT_V(6); PG8_BAR; PG8_MMA(1, 1, At, B1); PG8_BAR;
        }
        const bool keep = E(acc, cur, wr, wc, fr, fq);
        if (!has_next) break;
        if (!keep) {
#pragma unroll
            for (int a = 0; a < 2; ++a)
#pragma unroll
                for (int b = 0; b < 2; ++b)
#pragma unroll
                    for (int m = 0; m < 4; ++m)
#pragma unroll
                        for (int n = 0; n < 2; ++n) acc[a][b][m][n] = (f32x4){0.f, 0.f, 0.f, 0.f};
        }
        cur = nxt; cA = nA; cB = nB; ++ui;
    }
    PG8_WAIT_V(0);
    if (wr == 0) PG8_BAR;
    PG8_BAR;
#undef PG8_SA
#undef PG8_SB
#undef PG8_STAGE
#undef PG8_LDA
#undef PG8_LDB
#undef PG8_MMA
#undef PG8_WAIT_V
#undef PG8_WAIT_L
#undef PG8_BAR
#undef PG8_SCHED
}

#define EPI_ROWS for (int ai = 0; ai < 2; ++ai) _Pragma("unroll") for (int m = 0; m < 4; ++m)
#define EPI_ROW (u.pm * 256 + ai * 128 + wr * 64 + m * 16 + fr)
#define EPI_COLT(bj) ((bj) * 128 + wc * 32 + 8 * fq)

struct Epi1 {
    const float* rss0; const float* lbv; unsigned char* ws; unsigned char* outb;
    template <int ACT> __device__ __forceinline__ void body(const Acc& acc, const Unit& u, int wr, int wc, int fr, int fq, unsigned char* base, int scol, float scale) const {
#pragma unroll
        EPI_ROWS { const int row = EPI_ROW; const float rs = rsqrtf(rss0[row] * (1.0f / DM) + EPS);
#pragma unroll
            for (int bj = 0; bj < 2; ++bj) { const int col = scol + EPI_COLT(bj); float v[8];
#pragma unroll
                for (int j = 0; j < 4; ++j) { v[j] = acc[ai][bj][m][0][j] * rs; v[4 + j] = acc[ai][bj][m][1][j] * rs; }
                if (ACT == 0) {
#pragma unroll
                    for (int j = 0; j < 8; ++j) v[j] = v[j] * sigm(v[j]) * scale;
                } else if (ACT == 1) {
                    const f32x4 l0 = *(const f32x4*)(lbv + col), l1 = *(const f32x4*)(lbv + col + 4);
                    const float lb[8] = {l0[0], l0[1], l0[2], l0[3], l1[0], l1[1], l1[2], l1[3]};
                    h16x8 hv;
#pragma unroll
                    for (int j = 0; j < 8; ++j) hv[j] = (_Float16)__logf(lb[j] + (1.0f - lb[j]) * sigm(v[j]));
                    *(h16x8*)(base + ((size_t)row * DM + col) * 2) = hv; continue;
                } else if (ACT == 3) {
#pragma unroll
                    for (int j = 0; j < 8; ++j) v[j] = sigm(v[j]);
                }
                *(u32x4*)(base + ((size_t)row * DM + col) * 2) = pack8(v); } }
    }
    __device__ __forceinline__ bool operator()(Acc& acc, const Unit& u, int wr, int wc, int fr, int fq) const {
        const int sec = u.pn >> 2, scol = (u.pn & 3) * 256;
        unsigned char* base = sec == 0 ? outb : sec == 1 ? ws + WS_S1 : sec == 2 ? ws + WS_S2 : sec == 3 ? outb + A1 : sec == 4 ? ws + WS_S3 : sec == 5 ? ws + WS_S4 : sec == 6 ? ws + WS_S5 : sec == 7 ? ws + WS_S1 : ws + WS_S2;
        if (sec == 0) body<0>(acc, u, wr, wc, fr, fq, base, scol, 0.08838834764831845f);
        else if (sec == 1) body<1>(acc, u, wr, wc, fr, fq, base, scol, 1.f);
        else if (sec == 3) body<0>(acc, u, wr, wc, fr, fq, base, scol, 1.f);
        else if (sec >= 7) body<3>(acc, u, wr, wc, fr, fq, base, scol, 1.f);
        else body<2>(acc, u, wr, wc, fr, fq, base, scol, 1.f);
        return false;
    }
};

struct EpiBr {
    const unsigned char* SA; const unsigned char* SB; unsigned char* MIX;
    __device__ __forceinline__ bool operator()(Acc& acc, const Unit& u, int wr, int wc, int fr, int fq) const {
#pragma unroll
        EPI_ROWS { const int row = EPI_ROW;
#pragma unroll
            for (int bj = 0; bj < 2; ++bj) { const size_t e = ((size_t)row * DM + u.pn * 256 + EPI_COLT(bj)) * 2;
                float sb[8]; unpack8(*(const u32x4*)(SB + e), sb);
                if (u.part == 0) { float sa[8]; unpack8(*(const u32x4*)(SA + e), sa);
#pragma unroll
                    for (int j = 0; j < 4; ++j) { acc[ai][bj][m][0][j] *= sa[j] * __builtin_amdgcn_rcpf(sb[j]); acc[ai][bj][m][1][j] *= sa[4 + j] * __builtin_amdgcn_rcpf(sb[4 + j]); }
                } else { float v[8];
#pragma unroll
                    for (int j = 0; j < 4; ++j) { v[j] = acc[ai][bj][m][0][j] * sb[j]; v[4 + j] = acc[ai][bj][m][1][j] * sb[4 + j]; }
                    *(u32x4*)(MIX + e) = pack8(v); } } }
        return u.part == 0;
    }
};

struct EpiRes {
    const float* xi_p; const float* xi_s; float* xo; unsigned char* xob; float* rss;
    __device__ __forceinline__ bool operator()(Acc& acc, const Unit& u, int wr, int wc, int fr, int fq) const {
#pragma unroll
        EPI_ROWS { const int row = EPI_ROW; float part = 0.f;
            const float* xr = row < MP ? xi_p + (size_t)row * DM : xi_s + (size_t)(row - MP) * DM;
#pragma unroll
            for (int bj = 0; bj < 2; ++bj) { const int col = u.pn * 256 + EPI_COLT(bj);
                const f32x4 x0 = *(const f32x4*)(xr + col), x1 = *(const f32x4*)(xr + col + 4);
                const f32x4 y0 = x0 + acc[ai][bj][m][0], y1 = x1 + acc[ai][bj][m][1];
                *(f32x4*)(xo + (size_t)row * DM + col) = y0; *(f32x4*)(xo + (size_t)row * DM + col + 4) = y1;
                float v[8] = {y0[0], y0[1], y0[2], y0[3], y1[0], y1[1], y1[2], y1[3]};
#pragma unroll
                for (int j = 0; j < 8; ++j) part += v[j] * v[j];
                *(u32x4*)(xob + ((size_t)row * DM + col) * 2) = pack8(v); }
            part += __shfl_xor(part, 16); part += __shfl_xor(part, 32);
            if (fq == 0) atomicAdd(rss + row, part); }
        return false;
    }
};

struct EpiGU {
    const float* rss; unsigned char* H;
    __device__ __forceinline__ bool operator()(Acc& acc, const Unit& u, int wr, int wc, int fr, int fq) const {
#pragma unroll
        EPI_ROWS { const int row = EPI_ROW; const float rs = rsqrtf(rss[row] * (1.0f / DM) + EPS); float v[8];
#pragma unroll
            for (int j = 0; j < 4; ++j) { const float g0 = acc[ai][0][m][0][j] * rs, g1 = acc[ai][0][m][1][j] * rs;
                v[j] = g0 * sigm(g0) * (acc[ai][1][m][0][j] * rs); v[4 + j] = g1 * sigm(g1) * (acc[ai][1][m][1][j] * rs); }
            *(u32x4*)(H + ((size_t)row * DFF + u.pn * 128 + wc * 32 + 8 * fq) * 2) = pack8(v); }
        return false;
    }
};

struct EpiF32 {
    float* C;
    __device__ __forceinline__ bool operator()(Acc& acc, const Unit& u, int wr, int wc, int fr, int fq) const {
#pragma unroll
        EPI_ROWS { const int row = EPI_ROW;
#pragma unroll
            for (int bj = 0; bj < 2; ++bj) { float* d = C + (size_t)row * DM + u.pn * 256 + EPI_COLT(bj); *(f32x4*)d = acc[ai][bj][m][0]; *(f32x4*)(d + 4) = acc[ai][bj][m][1]; } }
        return false;
    }
};

struct EpiPG {
    const float* rss2; const float* x2; float* uo; float* rss3;
    __device__ __forceinline__ bool operator()(Acc& acc, const Unit& u, int wr, int wc, int fr, int fq) const {
#pragma unroll
        EPI_ROWS { const int row = EPI_ROW; const float rs = rsqrtf(rss2[row] * (1.0f / DM) + EPS); float part = 0.f;
#pragma unroll
            for (int bj = 0; bj < 2; ++bj) { const size_t e = (size_t)row * DM + u.pn * 256 + EPI_COLT(bj);
#pragma unroll
                for (int n = 0; n < 2; ++n) { const f32x4 xx = *(const f32x4*)(x2 + e + 4 * n), uu = *(const f32x4*)(uo + e + 4 * n); f32x4 y;
#pragma unroll
                    for (int j = 0; j < 4; ++j) { y[j] = xx[j] + sigm(acc[ai][bj][m][n][j] * rs) * uu[j]; part += y[j] * y[j]; }
                    *(f32x4*)(uo + e + 4 * n) = y; } }
            part += __shfl_xor(part, 16); part += __shfl_xor(part, 32);
            if (fq == 0) atomicAdd(rss3 + row, part); }
        return false;
    }
};

__device__ __forceinline__ void transpose_item(const float* W, int K, int N, int k0, int srccol0, const float* gain, bf16_t* WT, int dstrow0, LAS float* scr, int lane) {
#pragma unroll 8
    for (int i = 0; i < 32; ++i) { const int kk = 2 * i + (lane >> 5); float w = W[(size_t)(k0 + kk) * N + srccol0 + (lane & 31)]; if (gain) w *= gain[k0 + kk]; scr[kk * 33 + (lane & 31)] = w; }
    asm volatile("s_waitcnt lgkmcnt(0)" ::: "memory");
    const int c = lane & 7;
#pragma unroll
    for (int j = 0; j < 4; ++j) { const int n = (lane >> 3) + 8 * j; const LAS float* s = scr + (8 * c) * 33 + n;
        u32x4 o; o.x = pk2(s[0 * 33], s[1 * 33]); o.y = pk2(s[2 * 33], s[3 * 33]); o.z = pk2(s[4 * 33], s[5 * 33]); o.w = pk2(s[6 * 33], s[7 * 33]);
        *(u32x4*)(WT + (size_t)(dstrow0 + n) * K + k0 + 8 * c) = o; }
    asm volatile("s_waitcnt lgkmcnt(0)" ::: "memory");
}

__device__ __forceinline__ void phase_prep(const Params& p, LAS unsigned char* lds) {
    const int tid = threadIdx.x, wave = tid >> 6, lane = tid & 63;
    const int gw = blockIdx.x * 8 + wave, NGW = gridDim.x * 8;
    unsigned char* ws = p.ws;
    float* rss = (float*)(ws + M_RSS);
    for (int row = gw; row < MT; row += NGW) {
        const float* xr = row < MP ? p.x_prompt + (size_t)row * DM : p.x_sample + (size_t)(row - MP) * DM;
        f32x4 v[4]; float s = 0.f;
#pragma unroll
        for (int j = 0; j < 4; ++j) { v[j] = *(const f32x4*)(xr + 4 * lane + 256 * j); s += (v[j][0] * v[j][0] + v[j][1] * v[j][1]) + (v[j][2] * v[j][2] + v[j][3] * v[j][3]); }
        s = wave_sum(s);
        bf16_t* xb = (bf16_t*)(ws + WS_S0) + (size_t)row * DM;
#pragma unroll
        for (int j = 0; j < 4; ++j) { u32x2 o; o.x = pk2(v[j][0], v[j][1]); o.y = pk2(v[j][2], v[j][3]); *(u32x2*)(xb + 4 * lane + 256 * j) = o; }
        if (lane == 0) { rss[row] = s; rss[MT + row] = 0.f; rss[2 * MT + row] = 0.f; rss[3 * MT + row] = 0.f; }
    }
    if (blockIdx.x == 0) { float* lbv = (float*)(ws + M_LB); for (int c = tid; c < 1024; c += 512) lbv[c] = 1.0f / (1.0f + __expf(p.lower_bounds[1024 + c] - p.lower_bounds[c])); }
    LAS float* scr = (LAS float*)(lds + wave * 8448);
    constexpr int I_IN = 16 * (NIN / 32), I_SQ = 16 * 32, I_GU = 16 * (2 * DFF / 32), I_D = (DFF / 64) * 32, I_PLE = (PLE / 64) * 32;
    constexpr int NIT = I_IN + 4 * I_SQ + I_GU + I_D + I_PLE;
    for (int it = gw; it < NIT; it += NGW) {
        int r = it;
        if (r < I_IN) { const int nb = r % (NIN / 32), kb = r / (NIN / 32); transpose_item(p.w_in, DM, NIN, kb * 64, nb * 32, p.norm_mix, (bf16_t*)(ws + WS_TAIL), nb * 32, scr, lane); continue; } r -= I_IN;
        if (r < 4 * I_SQ) { const int w = r / I_SQ, q = r % I_SQ, nb = q % 32, kb = q / 32;
            const float* W = w == 0 ? p.w_a : w == 1 ? p.w_b : w == 2 ? p.w_out : p.w_pg; const float* g = w == 3 ? p.norm_ple : nullptr;
            bf16_t* D = (bf16_t*)(ws + (w == 0 ? M_BTA : w == 1 ? M_BTB : w == 2 ? M_BTO : M_BTPG));
            transpose_item(W, DM, DM, kb * 64, nb * 32, g, D, nb * 32, scr, lane); continue; } r -= 4 * I_SQ;
        if (r < I_GU) { const int nb = r % (2 * DFF / 32), kb = r / (2 * DFF / 32); const int n0 = nb * 32, pn = n0 >> 8, bj = (n0 >> 7) & 1, j0 = n0 & 127;
            transpose_item(p.w_gu, DM, 2 * DFF, kb * 64, bj * DFF + pn * 128 + j0, p.norm_ffn, (bf16_t*)(ws + M_BTGU), n0, scr, lane); continue; } r -= I_GU;
        if (r < I_D) { const int nb = r % 32, kb = r / 32; transpose_item(p.w_down, DFF, DM, kb * 64, nb * 32, nullptr, (bf16_t*)(ws + M_BTD), nb * 32, scr, lane); continue; } r -= I_D;
        { const int nb = r % 32, kb = r / 32; transpose_item(p.w_ple, PLE, DM, kb * 64, nb * 32, nullptr, (bf16_t*)(ws + M_BTPLE), nb * 32, scr, lane); }
    }
}

__device__ __forceinline__ void phase_pconv(const Params& p) {
    const size_t n4 = (size_t)MT * PLE / 4;
    u32x2* dst = (u32x2*)(p.ws + WS_TAIL);
    for (size_t i = (size_t)blockIdx.x * 512 + threadIdx.x; i < n4; i += (size_t)gridDim.x * 512) {
        const size_t e = i * 4; const float* src = e < (size_t)MP * PLE ? p.p_prompt + e : p.p_sample + (e - (size_t)MP * PLE);
        const f32x4 v = *(const f32x4*)src; u32x2 o; o.x = pk2(v[0], v[1]); o.y = pk2(v[2], v[3]); dst[i] = o;
    }
}

__device__ __forceinline__ void phase_conv(const Params& p) {
    unsigned char* ws = p.ws;
    unsigned char* Bg = ws + WS_S3; const unsigned char* Cg = ws + WS_S4; const unsigned char* Hc = ws + WS_S5;
    const int ntask = (MT / 8) * 128;
    for (int task = blockIdx.x * 512 + threadIdx.x; task < ntask; task += gridDim.x * 512) {
        const int run = task >> 7, c0 = (task & 127) * 8, t0 = run * 8;
        const bool prm = t0 < MP; const int tl = prm ? (t0 & 4095) : ((t0 - MP) & 63), T = prm ? 4096 : 64, sq = prm ? (t0 >> 12) : ((t0 - MP) >> 6);
        float w0[8], w1[8], w2[8], u1[8], u2[8];
#pragma unroll
        for (int j = 0; j < 8; ++j) { w0[j] = p.conv_w[c0 + j]; w1[j] = p.conv_w[1024 + c0 + j]; w2[j] = p.conv_w[2048 + c0 + j]; }
        if (tl == 0) {
            if (prm) {
#pragma unroll
                for (int j = 0; j < 8; ++j) { u1[j] = 0.f; u2[j] = 0.f; }
            } else {
#pragma unroll
                for (int j = 0; j < 8; ++j) { u2[j] = p.state_conv[(size_t)(sq * 2 + 0) * 1024 + c0 + j]; u1[j] = p.state_conv[(size_t)(sq * 2 + 1) * 1024 + c0 + j]; }
            }
        } else {
            float a[8], b[8];
            size_t e = ((size_t)(t0 - 1) * DM + c0) * 2; unpack8(*(const u32x4*)(Cg + e), a); unpack8(*(const u32x4*)(Hc + e), b);
#pragma unroll
            for (int j = 0; j < 8; ++j) u1[j] = a[j] * b[j];
            e = ((size_t)(t0 - 2) * DM + c0) * 2; unpack8(*(const u32x4*)(Cg + e), a); unpack8(*(const u32x4*)(Hc + e), b);
#pragma unroll
            for (int j = 0; j < 8; ++j) u2[j] = a[j] * b[j];
        }
#pragma unroll
        for (int r = 0; r < 8; ++r) {
            const size_t e = ((size_t)(t0 + r) * DM + c0) * 2; float a[8], b[8], g[8], u0[8], y[8];
            unpack8(*(const u32x4*)(Cg + e), a); unpack8(*(const u32x4*)(Hc + e), b); unpack8(*(const u32x4*)(Bg + e), g);
#pragma unroll
            for (int j = 0; j < 8; ++j) { u0[j] = a[j] * b[j]; y[j] = g[j] * (w0[j] * u2[j] + w1[j] * u1[j] + w2[j] * u0[j]); u2[j] = u1[j]; u1[j] = u0[j]; }
            *(u32x4*)(Bg + e) = pack8(y);
            const int tt = tl + r;
            if (tt >= T - 2) { float* o = p.out + (prm ? O_CP : O_CS) + (size_t)(sq * 2 + (tt - (T - 2))) * 1024 + c0;
                *(f32x4*)o = (f32x4){u0[0], u0[1], u0[2], u0[3]}; *(f32x4*)(o + 4) = (f32x4){u0[4], u0[5], u0[6], u0[7]}; }
        }
    }
}

constexpr int L_BC = 0;
constexpr int L_QH = 32768;
constexpr int L_QT = L_QH + 17408;
constexpr int L_KH = L_QT + 17408;
constexpr int L_VV = L_KH + 17408;
constexpr int L_PP = L_VV + 17408;
constexpr int L_SM = L_PP + 9216;
constexpr int L_O = L_SM + 3072;
static_assert(L_O + 64 * 132 * 4 <= LDS_BYTES - 16, "LDS");

__device__ __forceinline__ bf16x8 tr_frag(const LAS bf16_t* base, int stride, int s0, int v0, int lane) {
    const int fq = lane >> 4, i = lane & 15, q = i >> 2, pp = i & 3;
    const LAS bf16_t* a = base + (s0 + fq * 8 + q) * stride + v0 + 4 * pp;
    const s16x4 lo = __builtin_amdgcn_ds_read_tr16_b64_v4i16((LAS s16x4*)a);
    const s16x4 hi = __builtin_amdgcn_ds_read_tr16_b64_v4i16((LAS s16x4*)(a + 4 * stride));
    return (bf16x8){lo[0], lo[1], lo[2], lo[3], hi[0], hi[1], hi[2], hi[3]};
}

__device__ __forceinline__ void hg_load(const Params& p, LAS unsigned char* lds, int row0, int h) {
    const int tid = threadIdx.x;
    const unsigned char* LOGF = p.ws + WS_S1; const unsigned char* V = p.ws + WS_S2;
    LAS float* BC = (LAS float*)(lds + L_BC); LAS bf16_t* VV = (LAS bf16_t*)(lds + L_VV);
#pragma unroll
    for (int i = 0; i < 2; ++i) { const int v = tid + 512 * i, t = v >> 4, c8 = (v & 15) * 8; const size_t e = ((size_t)(row0 + t) * DM + h * 128 + c8) * 2;
        const h16x8 lf = *(const h16x8*)(LOGF + e); const u32x4 vv = *(const u32x4*)(V + e);
        *(LAS f32x4*)(BC + t * 128 + c8) = (f32x4){(float)lf[0], (float)lf[1], (float)lf[2], (float)lf[3]};
        *(LAS f32x4*)(BC + t * 128 + c8 + 4) = (f32x4){(float)lf[4], (float)lf[5], (float)lf[6], (float)lf[7]};
        *(LAS u32x4*)(VV + t * 136 + c8) = vv; }
}

__device__ __forceinline__ void phase_U(const Params& p, LAS unsigned char* lds) {
    const int tid = threadIdx.x, wave = tid >> 6, lane = tid & 63, fr = lane & 15, fq = lane >> 4;
    LAS float* BC = (LAS float*)(lds + L_BC); LAS bf16_t* KT = (LAS bf16_t*)(lds + L_KH); LAS bf16_t* VV = (LAS bf16_t*)(lds + L_VV);
    LAS float* segtot = (LAS float*)(lds + L_SM); LAS float* dkv = segtot + 640;
    bf16_t* UT = (bf16_t*)(p.ws + WS_S4); float* DK = (float*)(p.ws + M_DK);
    for (int it = blockIdx.x; it < NITEM; it += gridDim.x) {
        const int ci = it >> 3, h = it & 7, row0 = ci * 64;
        hg_load(p, lds, row0, h);
        __syncthreads();
        const int ch = tid & 127, seg = tid >> 7;
        float kk[16], bl[16]; float run = 0.f;
#pragma unroll
        for (int j = 0; j < 16; ++j) { const float lf = BC[(seg * 16 + j) * 128 + ch]; kk[j] = 1.0f - __expf(lf); run += lf; bl[j] = run; }
        segtot[seg * 128 + ch] = run;
        __syncthreads();
        const float s0 = segtot[ch], s1 = segtot[128 + ch], s2 = segtot[256 + ch], s3 = segtot[384 + ch];
        const float blast = (s0 + s1) + (s2 + s3);
        const float off = seg == 0 ? 0.f : seg == 1 ? s0 : seg == 2 ? s0 + s1 : s0 + s1 + s2;
        float kv[16];
#pragma unroll
        for (int j = 0; j < 16; ++j) kv[j] = kk[j] * __expf(blast - (off + bl[j]));
        u32x4 w0, w1; w0.x = pk2(kv[0], kv[1]); w0.y = pk2(kv[2], kv[3]); w0.z = pk2(kv[4], kv[5]); w0.w = pk2(kv[6], kv[7]);
        w1.x = pk2(kv[8], kv[9]); w1.y = pk2(kv[10], kv[11]); w1.z = pk2(kv[12], kv[13]); w1.w = pk2(kv[14], kv[15]);
        *(LAS u32x4*)(KT + ch * 72 + seg * 16) = w0; *(LAS u32x4*)(KT + ch * 72 + seg * 16 + 8) = w1;
        if (seg == 0) { const float dk = __expf(blast); dkv[ch] = dk; if (ci < 256) DK[(size_t)it * 128 + ch] = dk; }
        __syncthreads();
        const int kb = wave;
        bf16x8 a[2];
#pragma unroll
        for (int ss = 0; ss < 2; ++ss) a[ss] = *(const LAS bf16x8*)(KT + (kb * 16 + fr) * 72 + ss * 32 + fq * 8);
        const int k4 = kb * 16 + fq * 4;
        const f32x4 dk4 = *(const LAS f32x4*)(dkv + k4);
#pragma unroll
        for (int vb = 0; vb < 8; ++vb) {
            f32x4 acc = (f32x4){0.f, 0.f, 0.f, 0.f};
#pragma unroll
            for (int ss = 0; ss < 2; ++ss) { const bf16x8 b = tr_frag(VV, 136, ss * 32, vb * 16, lane); acc = __builtin_amdgcn_mfma_f32_16x16x32_bf16(a[ss], b, acc, 0, 0, 0); }
            const int v = vb * 16 + fr;
            bf16_t* ut = UT + (size_t)it * 16384 + v * 128 + k4;
            if (ci < 256) { u32x2 o; o.x = pk2(acc[0], acc[1]); o.y = pk2(acc[2], acc[3]); *(u32x2*)ut = o; }
            else { const int sb = ci - 256; const size_t sbase = ((size_t)(sb * 8 + h) * 128 + k4) * 128 + v; float s[4];
#pragma unroll
                for (int j = 0; j < 4; ++j) { s[j] = p.state_hgrn[sbase + (size_t)j * 128]; p.out[O_HS + sbase + (size_t)j * 128] = dk4[j] * s[j] + acc[j]; }
                u32x2 o; o.x = pk2(s[0], s[1]); o.y = pk2(s[2], s[3]); *(u32x2*)ut = o; }
        }
        __syncthreads();
    }
}

__device__ __forceinline__ void phase_scan(const Params& p) {
    bf16_t* UT = (bf16_t*)(p.ws + WS_S4); const float* DK = (const float*)(p.ws + M_DK);
    for (int gid = blockIdx.x * 512 + threadIdx.x; gid < 32 * 4096; gid += gridDim.x * 512) {
        const int e4 = gid & 4095, bh = gid >> 12, b = bh >> 3, h = bh & 7, v = e4 >> 5, k4 = (e4 & 31) * 4;
        f32x4 S = (f32x4){0.f, 0.f, 0.f, 0.f};
        for (int c0 = 0; c0 < 64; c0 += 8) {
            u32x2 uu[8]; f32x4 dd[8];
#pragma unroll
            for (int i = 0; i < 8; ++i) { const size_t it = (size_t)((b * 64 + c0 + i) * 8 + h); uu[i] = *(const u32x2*)(UT + it * 16384 + e4 * 4); dd[i] = *(const f32x4*)(DK + it * 128 + k4); }
#pragma unroll
            for (int i = 0; i < 8; ++i) { const size_t it = (size_t)((b * 64 + c0 + i) * 8 + h);
                u32x2 o; o.x = pk2(S[0], S[1]); o.y = pk2(S[2], S[3]); *(u32x2*)(UT + it * 16384 + e4 * 4) = o;
                S[0] = dd[i][0] * S[0] + bflo(uu[i].x); S[1] = dd[i][1] * S[1] + bfhi(uu[i].x); S[2] = dd[i][2] * S[2] + bflo(uu[i].y); S[3] = dd[i][3] * S[3] + bfhi(uu[i].y); }
        }
        float* o = p.out + O_HP + ((size_t)(b * 8 + h) * 128 + k4) * 128 + v;
#pragma unroll
        for (int j = 0; j < 4; ++j) o[(size_t)j * 128] = S[j];
    }
}

__device__ __forceinline__ void phase_O(const Params& p, LAS unsigned char* lds) {
    const int tid = threadIdx.x, wave = tid >> 6, lane = tid & 63, fr = lane & 15, fq = lane >> 4;
    LAS float* BC = (LAS float*)(lds + L_BC); LAS bf16_t* QH = (LAS bf16_t*)(lds + L_QH); LAS bf16_t* QT = (LAS bf16_t*)(lds + L_QT);
    LAS bf16_t* KH = (LAS bf16_t*)(lds + L_KH); LAS bf16_t* VV = (LAS bf16_t*)(lds + L_VV); LAS bf16_t* PP = (LAS bf16_t*)(lds + L_PP);
    LAS float* segtot = (LAS float*)(lds + L_SM); LAS float* rvec = segtot + 512; LAS float* OO = (LAS float*)(lds + L_O);
    const bf16_t* ST = (const bf16_t*)(p.ws + WS_S4);
    unsigned char* Q = (unsigned char*)p.out; const unsigned char* G = (const unsigned char*)p.out + A1;
    for (int it = blockIdx.x; it < NITEM; it += gridDim.x) {
        const int ci = it >> 3, h = it & 7, row0 = ci * 64;
        hg_load(p, lds, row0, h);
        __syncthreads();
        { const int ch = tid & 127, seg = tid >> 7;
            float kk[16], bl[16]; float run = 0.f;
#pragma unroll
            for (int j = 0; j < 16; ++j) { const float lf = BC[(seg * 16 + j) * 128 + ch]; kk[j] = 1.0f - __expf(lf); run += lf; bl[j] = run; }
            segtot[seg * 128 + ch] = run;
            __syncthreads();
            const float s0 = segtot[ch], s1 = segtot[128 + ch], s2 = segtot[256 + ch];
            const float r = s0 + s1;
            const float off = seg == 0 ? 0.f : seg == 1 ? s0 : seg == 2 ? s0 + s1 : s0 + s1 + s2;
#pragma unroll
            for (int j = 0; j < 16; ++j) { const float bc = off + bl[j]; const int t = seg * 16 + j; BC[t * 128 + ch] = bc;
                const float kv = kk[j] * __expf(fminf(r - bc, 80.f)); KH[t * 136 + ch] = (bf16_t)(pk2(kv, 0.f) & 0xffffu); }
            if (seg == 0) rvec[ch] = r;
        }
        __syncthreads();
#pragma unroll
        for (int i = 0; i < 2; ++i) { const int v = tid + 512 * i, t = v >> 4, c8 = (v & 15) * 8; float q[8], qh[8], qt[8];
            unpack8(*(const u32x4*)(Q + ((size_t)(row0 + t) * DM + h * 128 + c8) * 2), q);
#pragma unroll
            for (int j = 0; j < 8; ++j) { const float bc = BC[t * 128 + c8 + j]; qh[j] = q[j] * __expf(fmaxf(bc - rvec[c8 + j], -80.f)); qt[j] = q[j] * __expf(bc); }
            *(LAS u32x4*)(QH + t * 136 + c8) = pack8(qh); *(LAS u32x4*)(QT + t * 136 + c8) = pack8(qt); }
        __syncthreads();
        const int tb = wave >> 1;
#pragma unroll
        for (int sbi = 0; sbi < 2; ++sbi) { const int sb = (wave & 1) * 2 + sbi; f32x4 acc = (f32x4){0.f, 0.f, 0.f, 0.f};
            if (sb <= tb) {
#pragma unroll
                for (int k = 0; k < 4; ++k) { const bf16x8 a = *(const LAS bf16x8*)(QH + (tb * 16 + fr) * 136 + k * 32 + fq * 8), b = *(const LAS bf16x8*)(KH + (sb * 16 + fr) * 136 + k * 32 + fq * 8);
                    acc = __builtin_amdgcn_mfma_f32_16x16x32_bf16(b, a, acc, 0, 0, 0); }
#pragma unroll
                for (int j = 0; j < 4; ++j) acc[j] = (sb * 16 + fq * 4 + j <= tb * 16 + fr) ? acc[j] : 0.f;
            }
            u32x2 o; o.x = pk2(acc[0], acc[1]); o.y = pk2(acc[2], acc[3]); *(LAS u32x2*)(PP + (tb * 16 + fr) * 72 + sb * 16 + fq * 4) = o; }
        __syncthreads();
        { bf16x8 pa[2], qa[4];
#pragma unroll
            for (int ss = 0; ss < 2; ++ss) pa[ss] = *(const LAS bf16x8*)(PP + (tb * 16 + fr) * 72 + ss * 32 + fq * 8);
#pragma unroll
            for (int k = 0; k < 4; ++k) qa[k] = *(const LAS bf16x8*)(QT + (tb * 16 + fr) * 136 + k * 32 + fq * 8);
#pragma unroll
            for (int vi = 0; vi < 4; ++vi) { const int vb = (wave & 1) * 4 + vi; f32x4 acc = (f32x4){0.f, 0.f, 0.f, 0.f};
                bf16x8 sf[4];
#pragma unroll
                for (int k = 0; k < 4; ++k) sf[k] = *(const bf16x8*)(ST + (size_t)it * 16384 + (vb * 16 + fr) * 128 + k * 32 + fq * 8);
#pragma unroll
                for (int ss = 0; ss < 2; ++ss) { const bf16x8 vf = tr_frag(VV, 136, ss * 32, vb * 16, lane); acc = __builtin_amdgcn_mfma_f32_16x16x32_bf16(vf, pa[ss], acc, 0, 0, 0); }
#pragma unroll
                for (int k = 0; k < 4; ++k) acc = __builtin_amdgcn_mfma_f32_16x16x32_bf16(sf[k], qa[k], acc, 0, 0, 0);
                *(LAS f32x4*)(OO + (tb * 16 + fr) * 132 + vb * 16 + fq * 4) = acc; }
        }
        __syncthreads();
        { const int t = tid >> 3, part = tid & 7; float o[16]; float ss = 0.f;
#pragma unroll
            for (int j = 0; j < 4; ++j) { const f32x4 x = *(const LAS f32x4*)(OO + t * 132 + part * 16 + 4 * j); o[4 * j] = x[0]; o[4 * j + 1] = x[1]; o[4 * j + 2] = x[2]; o[4 * j + 3] = x[3]; ss += (x[0] * x[0] + x[1] * x[1]) + (x[2] * x[2] + x[3] * x[3]); }
            ss += __shfl_xor(ss, 1); ss += __shfl_xor(ss, 2); ss += __shfl_xor(ss, 4);
            const float rstd = rsqrtf(ss * (1.0f / 128.f) + EPS);
            const size_t e = ((size_t)(row0 + t) * DM + h * 128 + part * 16) * 2;
#pragma unroll
            for (int hh = 0; hh < 2; ++hh) { float g[8], y[8]; unpack8(*(const u32x4*)(G + e + hh * 16), g);
#pragma unroll
                for (int j = 0; j < 8; ++j) y[j] = o[hh * 8 + j] * rstd * p.hg_norm[part * 16 + hh * 8 + j] * g[j];
                *(u32x4*)(Q + e + hh * 16) = pack8(y); }
        }
        __syncthreads();
    }
}

__device__ __forceinline__ void phase_final(const Params& p) {
    const int wave = threadIdx.x >> 6, lane = threadIdx.x & 63; const float* rss3 = (const float*)(p.ws + M_RSS) + 3 * MT;
    for (int row = blockIdx.x * 8 + wave; row < MT; row += gridDim.x * 8) {
        const float rs = rsqrtf(rss3[row] * (1.0f / DM) + EPS); float* y = p.out + (size_t)row * DM;
#pragma unroll
        for (int j = 0; j < 4; ++j) { f32x4 v = *(f32x4*)(y + 4 * lane + 256 * j); const f32x4 g = *(const f32x4*)(p.norm_final + 4 * lane + 256 * j);
            v[0] *= rs * g[0]; v[1] *= rs * g[1]; v[2] *= rs * g[2]; v[3] *= rs * g[3]; *(f32x4*)(y + 4 * lane + 256 * j) = v; }
    }
}

#define XB_TMO      128
#define XB_XCNT(j)  (256  + 64 * (j))
#define XB_XSUB(j)  (1280 + 64 * (j))
#define XB_XGEN(j)  (2304 + 64 * (j))
#define XB_TOP      3328
#define XB_TOPGEN   3392
#define XCD_BAR_WORDS 3456
#define XB_SPIN_CAP (1u << 18)
__device__ __forceinline__ unsigned xb_ld(unsigned* p)              { return __hip_atomic_load(p, __ATOMIC_RELAXED, __HIP_MEMORY_SCOPE_AGENT); }
__device__ __forceinline__ unsigned xb_add(unsigned* p, unsigned v) { return __hip_atomic_fetch_add(p, v, __ATOMIC_RELAXED, __HIP_MEMORY_SCOPE_AGENT); }
__device__ __forceinline__ unsigned xb_xcc_id() { return (unsigned)__builtin_amdgcn_s_getreg((3 << 11) | 20) & 0xFu; }
#define XB_SPIN(cond, bar) do { unsigned _sp = 0; while (cond) { __builtin_amdgcn_s_sleep(1); \
    if ((++_sp & 255u) == 0u) { if (xb_ld(&(bar)[XB_TMO])) break; if (_sp > XB_SPIN_CAP) { atomicAdd(&(bar)[XB_TMO], 1u); break; } } } } while (0)
struct XcdBarrier { unsigned* bar; unsigned x; volatile LAS unsigned* st; };
__device__ __forceinline__ XcdBarrier xcd_barrier_post(unsigned* bar, volatile LAS unsigned* st) {
    XcdBarrier b; b.bar = bar; b.x = xb_xcc_id(); b.st = st;
    if (threadIdx.x == 0) (void)xb_add(&bar[XB_XCNT(b.x)], 1u);
    return b;
}
__device__ __forceinline__ void xcd_barrier_complete(unsigned* bar, unsigned x, unsigned& nloc, unsigned& nx) {
    const unsigned G = gridDim.x * gridDim.y * gridDim.z;
    unsigned sum, cnt, mine, sp = 0u;
    for (;;) {
        sum = 0u; cnt = 0u; mine = 0u;
#pragma unroll
        for (unsigned j = 0; j < 16; ++j) { const unsigned c = xb_ld(&bar[XB_XCNT(j)]); sum += c; cnt += (c > 0u) ? 1u : 0u; mine = (j == x) ? c : mine; }
        if (sum == G) break;
        __builtin_amdgcn_s_sleep(1);
        if ((++sp & 255u) == 0u) { if (xb_ld(&bar[XB_TMO])) break; if (sp > XB_SPIN_CAP) { atomicAdd(&bar[XB_TMO], 1u); break; } }
    }
    nloc = mine > 0u ? mine : 1u; nx = cnt > 0u ? cnt : 1u;
}
__device__ __forceinline__ void xcd_barrier(const XcdBarrier& b) {
    asm volatile("s_waitcnt vmcnt(0)" ::: "memory");
    __syncthreads();
    if (threadIdx.x == 0) {
        unsigned* bar = b.bar;
        __builtin_amdgcn_s_waitcnt(0);
        unsigned nloc = b.st[0], nx = b.st[1];
        if (nloc == 0u) { xcd_barrier_complete(bar, b.x, nloc, nx); b.st[0] = nloc; b.st[1] = nx; }
        const unsigned old = xb_add(&bar[XB_XSUB(b.x)], 1u);
        const unsigned gen = old / nloc;
        if (old + 1u == (gen + 1u) * nloc) {
            __builtin_amdgcn_fence(__ATOMIC_RELEASE, "agent");
            asm volatile("s_waitcnt vmcnt(0)" ::: "memory");
            const unsigned og = xb_add(&bar[XB_TOP], 1u);
            const unsigned tg = og / nx;
            if (og + 1u == (tg + 1u) * nx) xb_add(&bar[XB_TOPGEN], 1u);
            else XB_SPIN(xb_ld(&bar[XB_TOPGEN]) == tg, bar);
            __builtin_amdgcn_fence(__ATOMIC_ACQUIRE, "agent");
            xb_add(&bar[XB_XGEN(b.x)], 1u);
            asm volatile("s_waitcnt vmcnt(0)" ::: "memory");
        } else {
            XB_SPIN(xb_ld(&bar[XB_XGEN(b.x)]) == gen, bar);
            __builtin_amdgcn_fence(__ATOMIC_ACQUIRE, "agent");
            asm volatile("s_waitcnt vmcnt(0)" ::: "memory");
        }
    }
    __syncthreads();
}

__global__ void __launch_bounds__(512, 2) hgrn2_shortconv_fwd(Params p) {
    extern __shared__ __attribute__((aligned(16))) unsigned char smem[];
    LAS unsigned char* lds = (LAS unsigned char*)smem;
    cg::grid_group grid = cg::this_grid();
    unsigned char* ws = p.ws; unsigned char* outb = (unsigned char*)p.out;
    float* rss = (float*)(ws + M_RSS);
    const int G = gridDim.x, c = blockIdx.x;
    const size_t ts1024 = (size_t)256 * 1024 * 2;

    volatile LAS unsigned* xbw = (volatile LAS unsigned*)(lds + LDS_BYTES - 16);
    if (threadIdx.x == 0) { xbw[0] = 0u; xbw[1] = 0u; xbw[2] = 0u; xbw[3] = 0u; }
    __syncthreads();
    const XcdBarrier xb = xcd_barrier_post((unsigned*)(ws + M_BAR), xbw);
    if (p.ws == nullptr) grid.sync();
    phase_prep(p, lds);
    xcd_barrier(xb);
    {
        SchedTiles S{(const char*)(ws + WS_S0), (const char*)(ws + WS_TAIL), ts1024, MT / 256, 28, 0, G, c};
        Epi1 E{rss, (const float*)(ws + M_LB), ws, outb};
        gemm_phase(lds, 1024, S, E);
    }
    xcd_barrier(xb);
    phase_conv(p);
    xcd_barrier(xb);
    phase_U(p, lds);
    xcd_barrier(xb);
    phase_scan(p);
    xcd_barrier(xb);
    phase_O(p, lds);
    xcd_barrier(xb);
    {
        SchedTiles S{(const char*)(ws + WS_S0), (const char*)(ws + WS_TAIL), ts1024, MT / 256, 8, 28, G, c};
        Epi1 E{rss, (const float*)(ws + M_LB), ws, outb};
        gemm_phase(lds, 1024, S, E);
    }
    xcd_barrier(xb);
    phase_pconv(p);
    {
        SchedBranch S{(const char*)outb, (const char*)(ws + M_BTA), (const char*)(ws + WS_S3), (const char*)(ws + M_BTB), ts1024, MT / 256, 4, G, c};
        EpiBr E{ws + WS_S1, ws + WS_S2, ws + WS_S5};
        gemm_phase(lds, 1024, S, E);
    }
    xcd_barrier(xb);
    {
        SchedTiles S{(const char*)(ws + WS_S5), (const char*)(ws + M_BTO), ts1024, MT / 256, 4, 0, G, c};
        EpiRes E{p.x_prompt, p.x_sample, (float*)(ws + WS_S0), ws + WS_S2, rss + MT};
        gemm_phase(lds, 1024, S, E);
    }
    xcd_barrier(xb);
    {
        SchedTiles S{(const char*)(ws + WS_S2), (const char*)(ws + M_BTGU), ts1024, MT / 256, 22, 0, G, c};
        EpiGU E{rss + MT, ws + WS_S3};
        gemm_phase(lds, 1024, S, E);
    }
    xcd_barrier(xb);
    {
        SchedTiles S{(const char*)(ws + WS_S3), (const char*)(ws + M_BTD), (size_t)256 * DFF * 2, MT / 256, 4, 0, G, c};
        EpiRes E{(const float*)(ws + WS_S0), (const float*)(ws + WS_S0) + (size_t)MP * DM, (float*)(ws + WS_S0), ws + WS_S2, rss + 2 * MT};
        gemm_phase(lds, DFF, S, E);
    }
    {
        SchedTiles S{(const char*)(ws + WS_TAIL), (const char*)(ws + M_BTPLE), (size_t)256 * PLE * 2, MT / 256, 4, 0, G, c};
        EpiF32 E{p.out};
        gemm_phase(lds, PLE, S, E);
    }
    xcd_barrier(xb);
    {
        SchedTiles S{(const char*)(ws + WS_S2), (const char*)(ws + M_BTPG), ts1024, MT / 256, 4, 0, G, c};
        EpiPG E{rss + 2 * MT, (const float*)(ws + WS_S0), p.out, rss + 3 * MT};
        gemm_phase(lds, 1024, S, E);
    }
    xcd_barrier(xb);
    phase_final(p);
}

extern "C" void kernel_launch(void* const* d_in, const int* in_sizes, int n_in, void* d_out, int out_size, void* d_ws, size_t ws_size, hipStream_t stream) {
    static int grid_blocks = 0;
    if (grid_blocks == 0) {
        if (n_in != 21 || ws_size < WS_NEED) { fprintf(stderr, "kernel_launch: unexpected n_in %d / ws_size %zu (need %zu)\n", n_in, ws_size, (size_t)WS_NEED); grid_blocks = -1; return; }
        int dev = 0, cus = 0, per_cu = 0;
        hipGetDevice(&dev);
        hipDeviceGetAttribute(&cus, hipDeviceAttributeMultiprocessorCount, dev);
        if (hipFuncSetAttribute((const void*)hgrn2_shortconv_fwd, hipFuncAttributeMaxDynamicSharedMemorySize, LDS_BYTES) != hipSuccess) { fprintf(stderr, "kernel_launch: hipFuncSetAttribute failed\n"); grid_blocks = -1; return; }
        if (hipOccupancyMaxActiveBlocksPerMultiprocessor(&per_cu, (const void*)hgrn2_shortconv_fwd, 512, LDS_BYTES) != hipSuccess || per_cu < 1) { fprintf(stderr, "kernel_launch: occupancy query gave %d\n", per_cu); per_cu = 1; }
        (void)hipGetLastError();
        grid_blocks = cus * per_cu;
    }
    if (grid_blocks < 0) return;
    if (hipMemsetAsync((unsigned char*)d_ws + M_BAR, 0, 16384, stream) != hipSuccess) { fprintf(stderr, "kernel_launch: memset failed\n"); return; }
    Params p{};
    const float** f = (const float**)&p;
    for (int i = 0; i < 21; ++i) f[i] = (const float*)d_in[i];
    p.out = (float*)d_out; p.ws = (unsigned char*)d_ws;
    void* args[] = {&p};
    hipError_t e = hipLaunchCooperativeKernel((const void*)hgrn2_shortconv_fwd, dim3(grid_blocks), dim3(512), args, LDS_BYTES, stream);
    if (e != hipSuccess) fprintf(stderr, "cooperative launch failed: %s (grid %d)\n", hipGetErrorString(e), grid_blocks);
}
```

```cpp
#include <hip/hip_runtime.h>
#include <hip/hip_cooperative_groups.h>
#include <cstdio>
namespace cg = cooperative_groups;

#define LAS __attribute__((address_space(3)))
#ifndef SEG_MERGE
#define SEG_MERGE 1
#endif
typedef unsigned short bf16_t;
typedef short bf16x8 __attribute__((ext_vector_type(8)));
typedef short s16x4 __attribute__((ext_vector_type(4)));
typedef float f32x4 __attribute__((ext_vector_type(4)));
typedef unsigned u32x4 __attribute__((ext_vector_type(4)));
typedef unsigned u32x2 __attribute__((ext_vector_type(2)));
typedef _Float16 h16x8 __attribute__((ext_vector_type(8)));

constexpr int DM = 1024, MP = 16384, MS = 1024, MT = MP + MS;
constexpr int NIN = 9216, DFF = 2816, PLE = 256;
constexpr int NCHUNK = MT / 64, NITEM = NCHUNK * 8;
constexpr float EPS = 1e-6f;
constexpr size_t A1 = (size_t)MT * DM * 2;

constexpr size_t WS_S0 = 0, WS_S1 = A1, WS_S2 = 2 * A1, WS_S3 = 3 * A1, WS_S4 = 4 * A1, WS_S5 = 5 * A1, WS_S6 = 6 * A1, WS_TAIL = 7 * A1;
constexpr size_t M_RSS = WS_S6;
constexpr size_t M_DK = WS_S6 + 524288;
constexpr size_t M_LB = WS_S6 + 1572864;
constexpr size_t M_BTA = WS_S6 + 2097152, M_BTB = M_BTA + 2097152, M_BTO = M_BTB + 2097152, M_BTPG = M_BTO + 2097152;
constexpr size_t M_BTGU = M_BTPG + 2097152, M_BTD = M_BTGU + (size_t)2 * DFF * DM * 2, M_BTPLE = M_BTD + (size_t)DM * DFF * 2;
constexpr size_t M_BAR = M_BTPLE + (size_t)DM * PLE * 2;
constexpr size_t M_CNT = M_BAR + 16384;
constexpr size_t CTL_BYTES = 16384 + (size_t)6 * 68 * 256;
static_assert(M_BAR + CTL_BYTES <= WS_TAIL, "misc slot overflow");
constexpr size_t WS_NEED = WS_TAIL + (size_t)NIN * DM * 2;

constexpr size_t O_HP = (size_t)MT * DM, O_CP = O_HP + 4 * 8 * 128 * 128, O_HS = O_CP + 4 * 2 * 1024, O_CS = O_HS + (size_t)16 * 8 * 128 * 128;

constexpr int LDS_BYTES = 155648;

struct Params {
    const float *x_prompt, *x_sample, *p_prompt, *p_sample, *state_hgrn, *state_conv, *lower_bounds, *norm_mix, *w_in, *conv_w, *hg_norm,
        *w_a, *w_b, *w_out, *norm_ffn, *w_gu, *w_down, *norm_ple, *w_ple, *w_pg, *norm_final;
    float* out; unsigned char* ws;
};

__device__ __forceinline__ int opaque_tid() { int t = threadIdx.x; asm volatile("" : "+v"(t)); return t; }
typedef float f32x2_ __attribute__((ext_vector_type(2)));
typedef __bf16 bf16x2_ __attribute__((ext_vector_type(2)));
__device__ __forceinline__ unsigned pk2(float lo, float hi) { return __builtin_bit_cast(unsigned, __builtin_convertvector((f32x2_){lo, hi}, bf16x2_)); }
__device__ __forceinline__ float bflo(unsigned u) { return __uint_as_float(u << 16); }
__device__ __forceinline__ float bfhi(unsigned u) { return __uint_as_float(u & 0xffff0000u); }
__device__ __forceinline__ float fexp(float x) { return __builtin_amdgcn_exp2f(x * 1.4426950408889634f); }
__device__ __forceinline__ float flog(float x) { return __builtin_amdgcn_logf(x) * 0.6931471805599453f; }
__device__ __forceinline__ float sigm(float z) { return __builtin_amdgcn_rcpf(1.0f + __builtin_amdgcn_exp2f(z * -1.4426950408889634f)); }
typedef float f32x2 __attribute__((ext_vector_type(2)));
__device__ __forceinline__ f32x2 sigm2(f32x2 acc, float rs_nl2e) { const f32x2 b = acc * rs_nl2e; f32x2 e; e.x = __builtin_amdgcn_exp2f(b.x); e.y = __builtin_amdgcn_exp2f(b.y);
    const f32x2 d = e + 1.0f; f32x2 r; r.x = __builtin_amdgcn_rcpf(d.x); r.y = __builtin_amdgcn_rcpf(d.y); return r; }
__device__ __forceinline__ float wave_sum(float v) {
#pragma unroll
    for (int o = 1; o < 64; o <<= 1) v += __shfl_xor(v, o);
    return v;
}
__device__ __forceinline__ void unpack8(const u32x4 w, float (&f)[8]) {
    f[0] = bflo(w.x); f[1] = bfhi(w.x); f[2] = bflo(w.y); f[3] = bfhi(w.y); f[4] = bflo(w.z); f[5] = bfhi(w.z); f[6] = bflo(w.w); f[7] = bfhi(w.w);
}
__device__ __forceinline__ u32x4 pack8(const float (&f)[8]) { u32x4 w; w.x = pk2(f[0], f[1]); w.y = pk2(f[2], f[3]); w.z = pk2(f[4], f[5]); w.w = pk2(f[6], f[7]); return w; }

constexpr int BM = 256, BK = 64, HALF = 128, HTB = HALF * BK * 2, NXCD = 8, WGM = 8;
__device__ __forceinline__ int lds_byte(int r, int c) { const int st = (r >> 4) * 2 + (c >> 5), rr = r & 15, cc = c & 31, ob = rr * 64 + cc * 2; return st * 1024 + (ob ^ (((ob >> 9) & 1) << 5)); }
__device__ __forceinline__ void stage_rc(int b, int& R, int& C) { const int st = b / 1024, sb = b % 1024, swz = sb ^ (((sb >> 9) & 1) << 5); R = (st >> 1) * 16 + swz / 64; C = (st & 1) * 32 + (swz % 64) / 2; }
__device__ __forceinline__ int perm32(int rho) { const int n = rho >> 4, i = rho & 15; return 8 * (i >> 2) + 4 * n + (i & 3); }

enum { T_IN = 0, T_BR = 1, T_OUT = 2, T_GU = 3, T_PLE = 4, T_DOWN = 5, T_PG = 6 };
struct Unit { const char* A; const char* B; int pm, pn, part, type; };
__device__ __forceinline__ int unit_K(int type) { return type == T_PLE ? PLE : type == T_DOWN ? DFF : 1024; }
constexpr int CNT_STRIDE = 64;
__device__ __forceinline__ unsigned* cnt_at(unsigned* cnt, int k, int pm) { return cnt + (size_t)(k * 68 + pm) * CNT_STRIDE; }
constexpr size_t TS1024 = (size_t)256 * 1024 * 2;

struct Stream {
    unsigned char* ws; unsigned char* outb; int mode, G, pos, hi, pend, last_t;
    __device__ __forceinline__ void branch(Unit& u, int t, int part) const {
        const int q = t - 544; u.pm = q >> 2; u.pn = q & 3; u.part = part; u.type = T_BR;
        u.A = (const char*)(part ? ws + WS_S3 : outb) + (size_t)u.pm * TS1024; u.B = (const char*)(ws + (part ? M_BTB : M_BTA)) + (size_t)u.pn * TS1024;
    }
    __device__ __forceinline__ bool next(Unit& u) {
        if (mode == 0) {
            constexpr int nN = 28, nM = MT / 256, nwg = nM * nN; if (pos >= hi) return false;
            int wgid = pos; pos += G;
            { const int q = nwg / NXCD, r = nwg % NXCD, xcd = wgid % NXCD, off = wgid / NXCD; wgid = (xcd < r ? xcd * (q + 1) : r * (q + 1) + (xcd - r) * q) + off; }
            const int nig = WGM * nN, gid = wgid / nig, fm = gid * WGM, gsz = (nM - fm) < WGM ? (nM - fm) : WGM;
            u.pm = fm + ((wgid % nig) % gsz); u.pn = (wgid % nig) / gsz; u.part = 1; u.type = T_IN;
            u.A = (const char*)(ws + WS_S0) + (size_t)u.pm * TS1024; u.B = (const char*)(ws + WS_TAIL) + (size_t)u.pn * TS1024; return true;
        }
        if (mode == 1) {
            if (pend) { pend = 0; branch(u, last_t, 1); return true; }
            if (hi == 560) {
                int pp = pos; pos += G; if (pp >= 384 && pp < 400) { pp = pos; pos += G; }
                if (pp >= 560) return false;
                const int t = pp < 384 ? pp : pp - 16;
                u.pm = t >> 3; u.pn = 28 + (t & 7); u.part = 1; u.type = T_IN; u.A = (const char*)(ws + WS_S0) + (size_t)u.pm * TS1024; u.B = (const char*)(ws + WS_TAIL) + (size_t)u.pn * TS1024; return true;
            }
            const int t = pos; if (t >= hi) return false; pos += G;
            if (t < 544) { u.pm = t >> 3; u.pn = 28 + (t & 7); u.part = 1; u.type = T_IN; u.A = (const char*)(ws + WS_S0) + (size_t)u.pm * TS1024; u.B = (const char*)(ws + WS_TAIL) + (size_t)u.pn * TS1024; return true; }
            if (t < 816) { branch(u, t, 0); pend = 1; last_t = t; return true; }
            const int q = t - 816; u.pm = q >> 2; u.pn = q & 3; u.part = 1; u.type = T_OUT; u.A = (const char*)(ws + WS_S1) + (size_t)u.pm * TS1024; u.B = (const char*)(ws + M_BTO) + (size_t)u.pn * TS1024; return true;
        }
        int pp = pos; pos += G;
        while (pp < 1528 && ((pp >= 8 && pp < 24) || (pp >= 264 && pp < 280))) { pp = pos; pos += G; }
        if (pp >= 2344) return false;
        u.part = 1;
        if (pp < 1528) { const int t = pp < 8 ? pp : (pp < 264 ? pp - 16 : pp - 32); u.pm = t / 22; u.pn = t % 22; u.type = T_GU; u.A = (const char*)(ws + WS_S3) + (size_t)u.pm * TS1024; u.B = (const char*)(ws + M_BTGU) + (size_t)u.pn * TS1024; return true; }
        if (pp < 1800) { const int q = pp - 1528; u.pm = q >> 2; u.pn = q & 3; u.type = T_PLE; u.A = (const char*)(ws + WS_TAIL) + (size_t)u.pm * 256 * PLE * 2; u.B = (const char*)(ws + M_BTPLE) + (size_t)u.pn * 256 * PLE * 2; return true; }
        if (pp < 2072) { const int q = pp - 1800; u.pm = q >> 2; u.pn = q & 3; u.type = T_DOWN; u.A = (const char*)(ws + WS_S0) + (size_t)u.pm * 256 * DFF * 2; u.B = (const char*)(ws + M_BTD) + (size_t)u.pn * 256 * DFF * 2; return true; }
        const int q = pp - 2072; u.pm = q >> 2; u.pn = q & 3; u.type = T_PG; u.A = (const char*)(ws + WS_S3) + (size_t)u.pm * TS1024; u.B = (const char*)(ws + M_BTPG) + (size_t)u.pn * TS1024; return true;
    }
};

typedef f32x4 Acc[2][2][4][2];

template <bool WT, bool FORCE = false> __device__ __forceinline__ void st16(void* ptr, u32x4 v) {
    if (WT && !FORCE) asm volatile("global_store_dwordx4 %0, %1, off sc1\n\ts_nop 1" :: "v"(ptr), "v"(v) : "memory"); else *(u32x4*)ptr = v;
}
template <bool WT> __device__ __forceinline__ void st16f(void* ptr, f32x4 v) { st16<WT>(ptr, __builtin_bit_cast(u32x4, v)); }

#define EPI_ROWS for (int ai = 0; ai < 2; ++ai) _Pragma("unroll") for (int m = 0; m < 4; ++m)
#define EPI_ROW (u.pm * 256 + ai * 128 + wr * 64 + m * 16 + fr)
#define EPI_COLT(bj) ((bj) * 128 + wc * 32 + 8 * fq)

template <int ACT> __device__ __forceinline__ void epi_in_body(const Acc& acc, const Unit& u, int wr, int wc, int fr, int fq, const float* rss0, const float* lbv, unsigned char* base, int scol, float scale) {
#pragma unroll
    EPI_ROWS { const int row = EPI_ROW; const float rs = rsqrtf(rss0[row] * (1.0f / DM) + EPS);
#pragma unroll
        for (int bj = 0; bj < 2; ++bj) { const int col = scol + EPI_COLT(bj); float v[8];
            if (ACT == 0 || ACT == 3) {
                const float rsn = rs * -1.4426950408889634f, rss_ = rs * scale;
#pragma unroll
                for (int n = 0; n < 2; ++n)
#pragma unroll
                    for (int j = 0; j < 4; j += 2) { const f32x2 a2 = (f32x2){acc[ai][bj][m][n][j], acc[ai][bj][m][n][j + 1]}; const f32x2 r2 = sigm2(a2, rsn);
                        const f32x2 o2 = ACT == 0 ? (a2 * rss_) * r2 : r2; v[4 * n + j] = o2.x; v[4 * n + j + 1] = o2.y; }
                if (ACT == 3) { st16<true>(base + ((size_t)row * DM + col) * 2, pack8(v)); continue; }
                *(u32x4*)(base + ((size_t)row * DM + col) * 2) = pack8(v); continue;
            }
#pragma unroll
            for (int j = 0; j < 4; ++j) { v[j] = acc[ai][bj][m][0][j] * rs; v[4 + j] = acc[ai][bj][m][1][j] * rs; }
            if (ACT == 1) {
                const f32x4 l0 = *(const f32x4*)(lbv + col), l1 = *(const f32x4*)(lbv + col + 4);
                const float lb[8] = {l0[0], l0[1], l0[2], l0[3], l1[0], l1[1], l1[2], l1[3]};
                float lf[8];
#pragma unroll
                for (int j = 0; j < 8; ++j) { const float e = fexp(-v[j]); lf[j] = flog((1.0f + lb[j] * e) * __builtin_amdgcn_rcpf(1.0f + e)); }
                u32x4 w;
                w.x = __builtin_bit_cast(unsigned, __builtin_amdgcn_cvt_pkrtz(lf[0], lf[1])); w.y = __builtin_bit_cast(unsigned, __builtin_amdgcn_cvt_pkrtz(lf[2], lf[3]));
                w.z = __builtin_bit_cast(unsigned, __builtin_amdgcn_cvt_pkrtz(lf[4], lf[5])); w.w = __builtin_bit_cast(unsigned, __builtin_amdgcn_cvt_pkrtz(lf[6], lf[7]));
                *(u32x4*)(base + ((size_t)row * DM + col) * 2) = w; continue;
            }
            *(u32x4*)(base + ((size_t)row * DM + col) * 2) = pack8(v); } }
}
__device__ __forceinline__ void epi_in(const Acc& acc, const Unit& u, int wr, int wc, int fr, int fq, const Params& p) {
    unsigned char* ws = p.ws; unsigned char* outb = (unsigned char*)p.out;
    const float* rss0 = (const float*)(ws + M_RSS); const float* lbv = (const float*)(ws + M_LB);
    const int sec = u.pn >> 2, scol = (u.pn & 3) * 256;
    unsigned char* base = sec == 0 ? outb : sec == 1 ? ws + WS_S1 : sec == 2 ? ws + WS_S2 : sec == 3 ? outb + A1 : sec == 4 ? ws + WS_S3 : sec == 5 ? ws + WS_S4 : sec == 6 ? ws + WS_S5 : sec == 7 ? ws + WS_S1 : ws + WS_S2;
    if (sec == 0) epi_in_body<0>(acc, u, wr, wc, fr, fq, rss0, lbv, base, scol, 0.08838834764831845f);
    else if (sec == 1) epi_in_body<1>(acc, u, wr, wc, fr, fq, rss0, lbv, base, scol, 1.f);
    else if (sec == 3) epi_in_body<0>(acc, u, wr, wc, fr, fq, rss0, lbv, base, scol, 1.f);
    else if (sec >= 7) epi_in_body<3>(acc, u, wr, wc, fr, fq, rss0, lbv, base, scol, 1.f);
    else epi_in_body<2>(acc, u, wr, wc, fr, fq, rss0, lbv, base, scol, 1.f);
}
__device__ __forceinline__ void epi_br(const Acc& acc, const Unit& u, int wr, int wc, int fr, int fq, const Params& p) {
    unsigned char* SA = p.ws + WS_S1; const unsigned char* SB = p.ws + WS_S2; unsigned char* TT = (unsigned char*)p.out + A1;
#pragma unroll
    EPI_ROWS { const int row = EPI_ROW;
#pragma unroll
        for (int bj = 0; bj < 2; ++bj) { const size_t e = ((size_t)row * DM + u.pn * 256 + EPI_COLT(bj)) * 2; float g[8], v[8];
            if (u.part == 0) { unpack8(*(const u32x4*)(SA + e), g);
#pragma unroll
                for (int j = 0; j < 4; ++j) { v[j] = acc[ai][bj][m][0][j] * g[j]; v[4 + j] = acc[ai][bj][m][1][j] * g[4 + j]; }
            } else { unpack8(*(const u32x4*)(SB + e), g);
                float t[8]; unpack8(*(const u32x4*)(TT + e), t);
#pragma unroll
                for (int j = 0; j < 4; ++j) { v[j] = t[j] + acc[ai][bj][m][0][j] * g[j]; v[4 + j] = t[4 + j] + acc[ai][bj][m][1][j] * g[4 + j]; }
            }
            if (u.part == 0) st16<true, true>(TT + e, pack8(v)); else st16<true>(SA + e, pack8(v)); } }
}
template <bool WT> __device__ __forceinline__ void epi_res(const Acc& acc, const Unit& u, int wr, int wc, int fr, int fq, const float* xi_p, const float* xi_s, float* xo, unsigned char* xob, float* rss) {
#pragma unroll
    EPI_ROWS { const int row = EPI_ROW; float part = 0.f;
        const float* xr = row < MP ? xi_p + (size_t)row * DM : xi_s + (size_t)(row - MP) * DM;
#pragma unroll
        for (int bj = 0; bj < 2; ++bj) { const int col = u.pn * 256 + EPI_COLT(bj);
            const f32x4 x0 = *(const f32x4*)(xr + col), x1 = *(const f32x4*)(xr + col + 4);
            const f32x4 y0 = x0 + acc[ai][bj][m][0], y1 = x1 + acc[ai][bj][m][1];
            st16f<WT>(xo + (size_t)row * DM + col, y0); st16f<WT>(xo + (size_t)row * DM + col + 4, y1);
            float v[8] = {y0[0], y0[1], y0[2], y0[3], y1[0], y1[1], y1[2], y1[3]};
#pragma unroll
            for (int j = 0; j < 8; ++j) part += v[j] * v[j];
            st16<WT>(xob + ((size_t)row * DM + col) * 2, pack8(v)); }
        part += __shfl_xor(part, 16); part += __shfl_xor(part, 32);
        if (fq == 0) atomicAdd(rss + row, part); }
}
__device__ __forceinline__ void epi_gu(const Acc& acc, const Unit& u, int wr, int wc, int fr, int fq, const float* rss, unsigned char* H) {
#pragma unroll
    EPI_ROWS { const int row = EPI_ROW; const float rs = rsqrtf(rss[row] * (1.0f / DM) + EPS); float v[8];
#pragma unroll
        for (int n = 0; n < 2; ++n)
#pragma unroll
            for (int j = 0; j < 4; j += 2) { const f32x2 g2 = (f32x2){acc[ai][0][m][n][j], acc[ai][0][m][n][j + 1]}, u2 = (f32x2){acc[ai][1][m][n][j], acc[ai][1][m][n][j + 1]};
                const f32x2 o2 = ((g2 * rs) * sigm2(g2, rs * -1.4426950408889634f)) * (u2 * rs); v[4 * n + j] = o2.x; v[4 * n + j + 1] = o2.y; }
        st16<true>(H + ((size_t)row * DFF + u.pn * 128 + wc * 32 + 8 * fq) * 2, pack8(v)); }
}
__device__ __forceinline__ void epi_ple(const Acc& acc, const Unit& u, int wr, int wc, int fr, int fq, float* U) {
#pragma unroll
    EPI_ROWS { const int row = EPI_ROW;
#pragma unroll
        for (int bj = 0; bj < 2; ++bj) { float* d = U + (size_t)row * DM + u.pn * 256 + EPI_COLT(bj); st16f<true>(d, acc[ai][bj][m][0]); st16f<true>(d + 4, acc[ai][bj][m][1]); } }
}
__device__ __forceinline__ void epi_pg(const Acc& acc, const Unit& u, int wr, int wc, int fr, int fq, const float* rss2, const float* x2, float* uo, float* rss3) {
#pragma unroll
    EPI_ROWS { const int row = EPI_ROW; const float rs = rsqrtf(rss2[row] * (1.0f / DM) + EPS); float part = 0.f;
#pragma unroll
        for (int bj = 0; bj < 2; ++bj) { const size_t e = (size_t)row * DM + u.pn * 256 + EPI_COLT(bj);
#pragma unroll
            for (int n = 0; n < 2; ++n) { const f32x4 xx = *(const f32x4*)(x2 + e + 4 * n), uu = *(const f32x4*)(uo + e + 4 * n); f32x4 y;
#pragma unroll
                for (int j = 0; j < 4; ++j) { y[j] = xx[j] + sigm(acc[ai][bj][m][n][j] * rs) * uu[j]; part += y[j] * y[j]; }
                *(f32x4*)(uo + e + 4 * n) = y; } }
        part += __shfl_xor(part, 16); part += __shfl_xor(part, 32);
        if (fq == 0) atomicAdd(rss3 + row, part); }
}
__device__ __forceinline__ bool epi_dispatch(Acc& acc, const Unit& u, int wr, int wc, int fr, int fq, const Params& p) {
    asm volatile("" : "+v"(fr), "+v"(fq));
    asm volatile("" : "+s"(wr), "+s"(wc));
    unsigned char* ws = p.ws; unsigned char* outb = (unsigned char*)p.out; float* rss = (float*)(ws + M_RSS);
    switch (u.type) {
    case T_IN: epi_in(acc, u, wr, wc, fr, fq, p); return false;
    case T_BR: epi_br(acc, u, wr, wc, fr, fq, p); return false;
    case T_OUT: epi_res<false>(acc, u, wr, wc, fr, fq, p.x_prompt, p.x_sample, (float*)(ws + WS_S4), ws + WS_S3, rss + MT); return false;
    case T_GU: epi_gu(acc, u, wr, wc, fr, fq, rss + MT, ws + WS_S0); return false;
    case T_PLE: epi_ple(acc, u, wr, wc, fr, fq, p.out); return false;
    case T_DOWN: epi_res<true>(acc, u, wr, wc, fr, fq, (const float*)(ws + WS_S4), (const float*)(ws + WS_S4) + (size_t)MP * DM, (float*)(ws + WS_S4), ws + WS_S3, rss + 2 * MT); return false;
    default: epi_pg(acc, u, wr, wc, fr, fq, rss + 2 * MT, (const float*)(ws + WS_S4), p.out, rss + 3 * MT); return false;
    }
}

__device__ __forceinline__ void poll_ge(unsigned* w, unsigned need) {
    unsigned spins = 0;
    while ((unsigned)__builtin_amdgcn_readfirstlane(__hip_atomic_load(w, __ATOMIC_RELAXED, __HIP_MEMORY_SCOPE_AGENT)) < need) { __builtin_amdgcn_s_sleep(2); if (++spins > (1u << 21)) break; }
}
__device__ __forceinline__ void unit_ready(const Unit& u, unsigned* cnt) {
    const int ty = u.type;
    if (ty == T_IN || ty == T_GU || (ty == T_BR && u.part != 0)) return;
    if (threadIdx.x < 64) {
        if (ty == T_BR) poll_ge(cnt_at(cnt, 0, u.pm), 64u);
        else if (ty == T_OUT) poll_ge(cnt_at(cnt, 1, u.pm), 32u);
        else if (ty == T_PLE) poll_ge(cnt_at(cnt, 5, 0), gridDim.x);
        else if (ty == T_DOWN) poll_ge(cnt_at(cnt, 2, u.pm), 176u);
        else { poll_ge(cnt_at(cnt, 3, u.pm), 32u); poll_ge(cnt_at(cnt, 4, u.pm), 32u); }
        __builtin_amdgcn_fence(__ATOMIC_ACQUIRE, "agent");
        asm volatile("s_waitcnt vmcnt(0)" ::: "memory");
    }
    asm volatile("" ::: "memory"); __builtin_amdgcn_s_barrier(); asm volatile("" ::: "memory");
}
__device__ __forceinline__ void unit_done(const Unit& u, unsigned* cnt, LAS unsigned* larr) {
    const int ty = u.type; int k;
    if (ty == T_IN) { if (u.pn < 28) return; k = 0; } else if (ty == T_BR) { if (u.part == 0) { asm volatile("s_waitcnt vmcnt(0)" ::: "memory"); return; } k = 1; }
    else if (ty == T_GU) k = 2; else if (ty == T_DOWN) k = 3; else if (ty == T_PLE) k = 4; else return;
    asm volatile("s_waitcnt vmcnt(0)" ::: "memory");
    if ((threadIdx.x & 63) == 0) __hip_atomic_fetch_add(cnt_at(cnt, k, u.pm), 1u, __ATOMIC_RELAXED, __HIP_MEMORY_SCOPE_AGENT);
}

__device__ __forceinline__ void gemm_stream(LAS unsigned char* lds, Stream& S, const Params& p) {
    const int tid = opaque_tid(), wid = __builtin_amdgcn_readfirstlane(tid >> 6), lane = tid & 63, wr = wid >> 2, wc = wid & 3, fr = lane & 15, fq = lane >> 4;
    int R0, C0; stage_rc(tid * 16, R0, C0); const unsigned rA2 = (unsigned)R0 * 2u, rB2 = (unsigned)((R0 & ~31) + perm32(R0 & 31)) * 2u, c2 = (unsigned)C0 * 2u;
    const size_t kstep = (size_t)(BK * 2);
    const unsigned ldsw = (unsigned)wid * 1024u;
    const int aoff = lds_byte(wr * 64 + fr, fq * 8), boff = lds_byte(wc * 32 + fr, fq * 8);
#define PG8_SA(b, h) (((b) * 2 + (h)) * HTB)
#define PG8_SB(b, h) ((4 + (b) * 2 + (h)) * HTB)
#define PG8_STAGE(bufoff, gbase, r2, Kk) do { const unsigned _vo = (r2) * (unsigned)(Kk) + c2; _Pragma("unroll") for (int _i = 0; _i < 2; ++_i) \
        __builtin_amdgcn_global_load_lds((const unsigned*)((const char*)(gbase) + (size_t)_i * ((size_t)128 * (Kk)) + _vo), (LAS unsigned*)(lds + (bufoff) + ldsw + _i * 8192), 16, 0, 0); } while (0)
#define PG8_LDA(dst, b, h) do { _Pragma("unroll") for (int m = 0; m < 4; ++m) _Pragma("unroll") for (int k = 0; k < 2; ++k) dst[m][k] = *(const LAS bf16x8*)(lds + PG8_SA(b, h) + aoff + m * 2048 + k * 1024); } while (0)
#define PG8_LDB(dst, b, h) do { _Pragma("unroll") for (int n = 0; n < 2; ++n) _Pragma("unroll") for (int k = 0; k < 2; ++k) dst[n][k] = *(const LAS bf16x8*)(lds + PG8_SB(b, h) + boff + n * 2048 + k * 1024); } while (0)
#define PG8_MMA(ai, bj, At, Bt) do { __builtin_amdgcn_s_setprio(1); _Pragma("unroll") for (int m = 0; m < 4; ++m) _Pragma("unroll") for (int n = 0; n < 2; ++n) _Pragma("unroll") for (int k = 0; k < 2; ++k) \
        acc[ai][bj][m][n] = __builtin_amdgcn_mfma_f32_16x16x32_bf16(Bt[n][k], At[m][k], acc[ai][bj][m][n], 0, 0, 0); __builtin_amdgcn_s_setprio(0); } while (0)
#define PG8_WAIT_V(n) asm volatile("s_waitcnt vmcnt(" #n ")" ::: "memory")
#define PG8_WAIT_L(n) asm volatile("s_waitcnt lgkmcnt(" #n ")" ::: "memory")
#define PG8_BAR __builtin_amdgcn_s_barrier()
#define PG8_SCHED __builtin_amdgcn_sched_barrier(0)
    Unit cur, nxt;
    bool have = S.next(cur);
    unsigned* cnt = (unsigned*)(p.ws + M_CNT);
    Acc acc;
#pragma unroll
    for (int a = 0; a < 2; ++a)
#pragma unroll
        for (int b = 0; b < 2; ++b)
#pragma unroll
            for (int m = 0; m < 4; ++m)
#pragma unroll
                for (int n = 0; n < 2; ++n) acc[a][b][m][n] = (f32x4){0.f, 0.f, 0.f, 0.f};
    bf16x8 At[4][2], B0[2][2], B1[2][2];
    while (have) {
        const char* cA = cur.A; const char* cB = cur.B;
        int cK = unit_K(cur.type); unsigned hsc = (unsigned)HALF * cK * 2;
        if (SEG_MERGE) unit_ready(cur, cnt);
        PG8_STAGE(PG8_SB(0, 0), cB, rB2, cK); PG8_STAGE(PG8_SA(0, 0), cA, rA2, cK); PG8_STAGE(PG8_SB(0, 1), cB + hsc, rB2, cK); PG8_STAGE(PG8_SA(0, 1), cA + hsc, rA2, cK);
        if (wr == 1) PG8_BAR;
        PG8_WAIT_V(4); PG8_BAR;
        PG8_STAGE(PG8_SB(1, 0), cB + kstep, rB2, cK); PG8_STAGE(PG8_SA(1, 0), cA + kstep, rA2, cK); PG8_STAGE(PG8_SB(1, 1), cB + hsc + kstep, rB2, cK);
        PG8_WAIT_V(6); PG8_BAR;
        for (;;) {
            const bool has_next = S.next(nxt);
            const bool chain = has_next && !(nxt.type == T_OUT || nxt.type == T_PG);
            const char* nA = chain ? nxt.A : cA; const char* nB = chain ? nxt.B : cB; const int nK = chain ? unit_K(nxt.type) : cK;
            const unsigned hsn = (unsigned)HALF * nK * 2;
            const int nt = cK / BK;
            for (int t = 0; t < nt; t += 2) {
                const bool last = (t == nt - 2);
                const char* a1 = cA + (size_t)(t + 1) * kstep;
                const char* a2 = last ? nA : cA + (size_t)(t + 2) * kstep; const char* b2 = last ? nB : cB + (size_t)(t + 2) * kstep;
                const char* a3 = a2 + kstep; const char* b3 = b2 + kstep;
                const int K2 = last ? nK : cK; const unsigned hs2 = last ? hsn : hsc;
                if (SEG_MERGE && last && chain) unit_ready(nxt, cnt);
                PG8_LDB(B0, 0, 0); PG8_SCHED; PG8_LDA(At, 0, 0); PG8_STAGE(PG8_SA(1, 1), a1 + hsc, rA2, cK);
                PG8_WAIT_L(8); PG8_BAR; PG8_WAIT_L(0); PG8_MMA(0, 0, At, B0); PG8_BAR; PG8_SCHED;
                PG8_LDB(B1, 0, 1); PG8_STAGE(PG8_SB(0, 0), b2, rB2, K2);
                PG8_BAR; PG8_WAIT_L(0); PG8_MMA(0, 1, At, B1); PG8_BAR;
                PG8_LDA(At, 0, 1); PG8_STAGE(PG8_SA(0, 0), a2, rA2, K2);
                PG8_BAR; PG8_WAIT_L(0); PG8_MMA(1, 0, At, B0); PG8_BAR; PG8_SCHED;
                PG8_STAGE(PG8_SB(0, 1), b2 + hs2, rB2, K2);
                PG8_WAIT_V(6); PG8_BAR; PG8_MMA(1, 1, At, B1); PG8_BAR;
                PG8_LDB(B0, 1, 0); PG8_SCHED; PG8_LDA(At, 1, 0); PG8_STAGE(PG8_SA(0, 1), a2 + hs2, rA2, K2);
                PG8_WAIT_L(8); PG8_BAR; PG8_WAIT_L(0); PG8_MMA(0, 0, At, B0); PG8_BAR; PG8_SCHED;
                PG8_LDB(B1, 1, 1); PG8_STAGE(PG8_SB(1, 0), b3, rB2, K2);
                PG8_BAR; PG8_WAIT_L(0); PG8_MMA(0, 1, At, B1); PG8_BAR;
                PG8_LDA(At, 1, 1); PG8_STAGE(PG8_SA(1, 0), a3, rA2, K2);
                PG8_BAR; PG8_WAIT_L(0); PG8_MMA(1, 0, At, B0); PG8_BAR; PG8_SCHED;
                PG8_STAGE(PG8_SB(1, 1), b3 + hs2, rB2, K2);
                PG8_WAIT_V(6); PG8_BAR; PG8_MMA(1, 1, At, B1); PG8_BAR;
            }
            (void)epi_dispatch(acc, cur, wr, wc, fr, fq, p);
            if (SEG_MERGE) unit_done(cur, cnt, (LAS unsigned*)(lds + LDS_BYTES - 8));
#pragma unroll
            for (int a = 0; a < 2; ++a)
#pragma unroll
                for (int b = 0; b < 2; ++b)
#pragma unroll
                    for (int m = 0; m < 4; ++m)
#pragma unroll
                        for (int n = 0; n < 2; ++n) acc[a][b][m][n] = (f32x4){0.f, 0.f, 0.f, 0.f};
            have = has_next;
            if (!has_next) break;
            cur = nxt;
            if (!chain) break;
            cA = nA; cB = nB; cK = nK; hsc = hsn;
        }
        PG8_WAIT_V(0);
        if (wr == 0) PG8_BAR;
        PG8_BAR;
    }
#undef PG8_SA
#undef PG8_SB
#undef PG8_STAGE
#undef PG8_LDA
#undef PG8_LDB
#undef PG8_MMA
#undef PG8_WAIT_V
#undef PG8_WAIT_L
#undef PG8_BAR
#undef PG8_SCHED
}

__device__ __forceinline__ void transpose_item(const float* W, int K, int N, int k0, int srccol0, const float* gain, bf16_t* WT, int dstrow0, LAS float* scr, int lane) {
    float w[32], g[32];
    const float* src = W + (size_t)(k0 + (lane >> 5)) * N + srccol0 + (lane & 31);
#pragma unroll
    for (int i = 0; i < 32; ++i) w[i] = src[(size_t)(2 * i) * N];
    if (gain) {
#pragma unroll
        for (int i = 0; i < 32; ++i) g[i] = gain[k0 + 2 * i + (lane >> 5)];
#pragma unroll
        for (int i = 0; i < 32; ++i) w[i] *= g[i];
    }
#pragma unroll
    for (int i = 0; i < 32; ++i) scr[(2 * i + (lane >> 5)) * 33 + (lane & 31)] = w[i];
    asm volatile("s_waitcnt lgkmcnt(0)" ::: "memory");
    const int c = lane & 7;
#pragma unroll
    for (int j = 0; j < 4; ++j) { const int n = (lane >> 3) + 8 * j; const LAS float* s = scr + (8 * c) * 33 + n;
        u32x4 o; o.x = pk2(s[0 * 33], s[1 * 33]); o.y = pk2(s[2 * 33], s[3 * 33]); o.z = pk2(s[4 * 33], s[5 * 33]); o.w = pk2(s[6 * 33], s[7 * 33]);
        *(u32x4*)(WT + (size_t)(dstrow0 + n) * K + k0 + 8 * c) = o; }
    asm volatile("s_waitcnt lgkmcnt(0)" ::: "memory");
}
__device__ __forceinline__ void phase_prep(const Params& p, LAS unsigned char* lds) {
    const int tid = opaque_tid(), wave = tid >> 6, lane = tid & 63;
    const int gw = blockIdx.x * 8 + wave, NGW = gridDim.x * 8;
    unsigned char* ws = p.ws;
    float* rss = (float*)(ws + M_RSS);
    for (int row0 = gw; row0 < MT; row0 += 2 * NGW) {
        const int row1 = row0 + NGW; const bool has1 = row1 < MT; const int r1 = has1 ? row1 : row0;
        const float* xr0 = row0 < MP ? p.x_prompt + (size_t)row0 * DM : p.x_sample + (size_t)(row0 - MP) * DM;
        const float* xr1 = r1 < MP ? p.x_prompt + (size_t)r1 * DM : p.x_sample + (size_t)(r1 - MP) * DM;
        f32x4 v[8]; float s0 = 0.f, s1 = 0.f;
#pragma unroll
        for (int j = 0; j < 4; ++j) { v[j] = *(const f32x4*)(xr0 + 4 * lane + 256 * j); v[4 + j] = *(const f32x4*)(xr1 + 4 * lane + 256 * j); }
#pragma unroll
        for (int j = 0; j < 4; ++j) { s0 += (v[j][0] * v[j][0] + v[j][1] * v[j][1]) + (v[j][2] * v[j][2] + v[j][3] * v[j][3]); s1 += (v[4 + j][0] * v[4 + j][0] + v[4 + j][1] * v[4 + j][1]) + (v[4 + j][2] * v[4 + j][2] + v[4 + j][3] * v[4 + j][3]); }
        s0 = wave_sum(s0); s1 = wave_sum(s1);
        bf16_t* xb0 = (bf16_t*)(ws + WS_S0) + (size_t)row0 * DM; bf16_t* xb1 = (bf16_t*)(ws + WS_S0) + (size_t)r1 * DM;
#pragma unroll
        for (int j = 0; j < 4; ++j) { u32x2 o; o.x = pk2(v[j][0], v[j][1]); o.y = pk2(v[j][2], v[j][3]); *(u32x2*)(xb0 + 4 * lane + 256 * j) = o; }
        if (has1) {
#pragma unroll
            for (int j = 0; j < 4; ++j) { u32x2 o; o.x = pk2(v[4 + j][0], v[4 + j][1]); o.y = pk2(v[4 + j][2], v[4 + j][3]); *(u32x2*)(xb1 + 4 * lane + 256 * j) = o; }
        }
        if (lane == 0) { rss[row0] = s0; rss[MT + row0] = 0.f; rss[2 * MT + row0] = 0.f; rss[3 * MT + row0] = 0.f;
            if (has1) { rss[row1] = s1; rss[MT + row1] = 0.f; rss[2 * MT + row1] = 0.f; rss[3 * MT + row1] = 0.f; } }
    }
    if (blockIdx.x == 0) { float* lbv = (float*)(ws + M_LB); for (int c = tid; c < 1024; c += 512) lbv[c] = 1.0f / (1.0f + fexp(p.lower_bounds[1024 + c] - p.lower_bounds[c])); }
    LAS float* scr = (LAS float*)(lds + wave * 8448);
    constexpr int I_IN = 16 * (NIN / 32), I_SQ = 16 * 32, I_GU = 16 * (2 * DFF / 32), I_D = (DFF / 64) * 32, I_PLE = (PLE / 64) * 32;
    constexpr int NIT = I_IN + 4 * I_SQ + I_GU + I_D + I_PLE;
    for (int it = gw; it < NIT; it += NGW) {
        int r = it;
        if (r < I_IN) { const int nb = r % (NIN / 32), kb = r / (NIN / 32); transpose_item(p.w_in, DM, NIN, kb * 64, nb * 32, p.norm_mix, (bf16_t*)(ws + WS_TAIL), nb * 32, scr, lane); continue; } r -= I_IN;
        if (r < 4 * I_SQ) { const int w = r / I_SQ, q = r % I_SQ, nb = q % 32, kb = q / 32;
            const float* W = w == 0 ? p.w_a : w == 1 ? p.w_b : w == 2 ? p.w_out : p.w_pg; const float* g = w == 3 ? p.norm_ple : nullptr;
            bf16_t* D = (bf16_t*)(ws + (w == 0 ? M_BTA : w == 1 ? M_BTB : w == 2 ? M_BTO : M_BTPG));
            transpose_item(W, DM, DM, kb * 64, nb * 32, g, D, nb * 32, scr, lane); continue; } r -= 4 * I_SQ;
        if (r < I_GU) { const int nb = r % (2 * DFF / 32), kb = r / (2 * DFF / 32); const int n0 = nb * 32, pn = n0 >> 8, bj = (n0 >> 7) & 1, j0 = n0 & 127;
            transpose_item(p.w_gu, DM, 2 * DFF, kb * 64, bj * DFF + pn * 128 + j0, p.norm_ffn, (bf16_t*)(ws + M_BTGU), n0, scr, lane); continue; } r -= I_GU;
        if (r < I_D) { const int nb = r % 32, kb = r / 32; transpose_item(p.w_down, DFF, DM, kb * 64, nb * 32, nullptr, (bf16_t*)(ws + M_BTD), nb * 32, scr, lane); continue; } r -= I_D;
        { const int nb = r % 32, kb = r / 32; transpose_item(p.w_ple, PLE, DM, kb * 64, nb * 32, nullptr, (bf16_t*)(ws + M_BTPLE), nb * 32, scr, lane); }
    }
}

__device__ __forceinline__ void phase_pconv(const Params& p, unsigned* cnt) {
    const size_t n4 = (size_t)MT * PLE / 4;
    unsigned long long* dst = (unsigned long long*)(p.ws + WS_TAIL);
    for (size_t i = (size_t)blockIdx.x * 512 + opaque_tid(); i < n4; i += (size_t)gridDim.x * 512) {
        const size_t e = i * 4; const float* src = e < (size_t)MP * PLE ? p.p_prompt + e : p.p_sample + (e - (size_t)MP * PLE);
        const f32x4 v = *(const f32x4*)src;
        dst[i] = (unsigned long long)pk2(v[0], v[1]) | ((unsigned long long)pk2(v[2], v[3]) << 32);
    }
    asm volatile("s_waitcnt vmcnt(0)" ::: "memory");
    __syncthreads();
    if (threadIdx.x == 0) { __builtin_amdgcn_fence(__ATOMIC_RELEASE, "agent"); asm volatile("s_waitcnt vmcnt(0)" ::: "memory"); __hip_atomic_fetch_add(cnt_at(cnt, 5, 0), 1u, __ATOMIC_RELAXED, __HIP_MEMORY_SCOPE_AGENT); }
}

__device__ __forceinline__ void phase_conv(const Params& p) {
    unsigned char* ws = p.ws;
    unsigned char* Bg = ws + WS_S3; const unsigned char* Cg = ws + WS_S4; const unsigned char* Hc = ws + WS_S5;
    const int ntask = (MT / 8) * 128;
    for (int task = blockIdx.x * 512 + opaque_tid(); task < ntask; task += gridDim.x * 512) {
        const int run = task >> 7, c0 = (task & 127) * 8, t0 = run * 8;
        const bool prm = t0 < MP; const int tl = prm ? (t0 & 4095) : ((t0 - MP) & 63), T = prm ? 4096 : 64, sq = prm ? (t0 >> 12) : ((t0 - MP) >> 6);
        float w0[8], w1[8], w2[8], u1[8], u2[8];
#pragma unroll
        for (int j = 0; j < 8; ++j) { w0[j] = p.conv_w[c0 + j]; w1[j] = p.conv_w[1024 + c0 + j]; w2[j] = p.conv_w[2048 + c0 + j]; }
        if (tl == 0) {
            if (prm) {
#pragma unroll
                for (int j = 0; j < 8; ++j) { u1[j] = 0.f; u2[j] = 0.f; }
            } else {
#pragma unroll
                for (int j = 0; j < 8; ++j) { u2[j] = p.state_conv[(size_t)(sq * 2 + 0) * 1024 + c0 + j]; u1[j] = p.state_conv[(size_t)(sq * 2 + 1) * 1024 + c0 + j]; }
            }
        } else {
            float a[8], b[8];
            size_t e = ((size_t)(t0 - 1) * DM + c0) * 2; unpack8(*(const u32x4*)(Cg + e), a); unpack8(*(const u32x4*)(Hc + e), b);
#pragma unroll
            for (int j = 0; j < 8; ++j) u1[j] = a[j] * b[j];
            e = ((size_t)(t0 - 2) * DM + c0) * 2; unpack8(*(const u32x4*)(Cg + e), a); unpack8(*(const u32x4*)(Hc + e), b);
#pragma unroll
            for (int j = 0; j < 8; ++j) u2[j] = a[j] * b[j];
        }
#pragma unroll
        for (int r = 0; r < 8; ++r) {
            const size_t e = ((size_t)(t0 + r) * DM + c0) * 2; float a[8], b[8], g[8], u0[8], y[8];
            unpack8(*(const u32x4*)(Cg + e), a); unpack8(*(const u32x4*)(Hc + e), b); unpack8(*(const u32x4*)(Bg + e), g);
#pragma unroll
            for (int j = 0; j < 8; ++j) { u0[j] = a[j] * b[j]; y[j] = g[j] * (w0[j] * u2[j] + w1[j] * u1[j] + w2[j] * u0[j]); u2[j] = u1[j]; u1[j] = u0[j]; }
            *(u32x4*)(Bg + e) = pack8(y);
            const int tt = tl + r;
            if (tt >= T - 2) { float* o = p.out + (prm ? O_CP : O_CS) + (size_t)(sq * 2 + (tt - (T - 2))) * 1024 + c0;
                *(f32x4*)o = (f32x4){u0[0], u0[1], u0[2], u0[3]}; *(f32x4*)(o + 4) = (f32x4){u0[4], u0[5], u0[6], u0[7]}; }
        }
    }
}

constexpr int L_BC = 0;
constexpr int L_QH = 32768;
constexpr int L_QT = L_QH + 17408;
constexpr int L_KH = L_QT + 17408;
constexpr int L_VV = L_KH + 17408;
constexpr int L_PP = L_VV + 17408;
constexpr int L_SM = L_PP + 9216;
constexpr int L_O = L_SM + 3072;
static_assert(L_O + 64 * 132 * 4 <= LDS_BYTES - 16, "LDS");

__device__ __forceinline__ bf16x8 tr_frag(const LAS bf16_t* base, int stride, int s0, int v0, int lane) {
    const int fq = lane >> 4, i = lane & 15, q = i >> 2, pp = i & 3;
    const LAS bf16_t* a = base + (s0 + fq * 8 + q) * stride + v0 + 4 * pp;
    const s16x4 lo = __builtin_amdgcn_ds_read_tr16_b64_v4i16((LAS s16x4*)a);
    const s16x4 hi = __builtin_amdgcn_ds_read_tr16_b64_v4i16((LAS s16x4*)(a + 4 * stride));
    return (bf16x8){lo[0], lo[1], lo[2], lo[3], hi[0], hi[1], hi[2], hi[3]};
}

__device__ __forceinline__ void hg_load(const Params& p, LAS unsigned char* lds, int row0, int h) {
    const int tid = opaque_tid();
    const unsigned char* LOGF = p.ws + WS_S1; const unsigned char* V = p.ws + WS_S2;
    LAS float* BC = (LAS float*)(lds + L_BC); LAS bf16_t* VV = (LAS bf16_t*)(lds + L_VV);
#pragma unroll
    for (int i = 0; i < 2; ++i) { const int v = tid + 512 * i, t = v >> 4, c8 = (v & 15) * 8; const size_t e = ((size_t)(row0 + t) * DM + h * 128 + c8) * 2;
        const h16x8 lf = *(const h16x8*)(LOGF + e); const u32x4 vv = *(const u32x4*)(V + e);
        *(LAS f32x4*)(BC + t * 128 + c8) = (f32x4){(float)lf[0], (float)lf[1], (float)lf[2], (float)lf[3]};
        *(LAS f32x4*)(BC + t * 128 + c8 + 4) = (f32x4){(float)lf[4], (float)lf[5], (float)lf[6], (float)lf[7]};
        *(LAS u32x4*)(VV + t * 136 + c8) = vv; }
}

__device__ __forceinline__ void phase_U(const Params& p, LAS unsigned char* lds) {
    const int tid = opaque_tid(), wave = tid >> 6, lane = tid & 63, fr = lane & 15, fq = lane >> 4;
    LAS float* BC = (LAS float*)(lds + L_BC); LAS bf16_t* KT = (LAS bf16_t*)(lds + L_KH); LAS bf16_t* VV = (LAS bf16_t*)(lds + L_VV);
    LAS float* segtot = (LAS float*)(lds + L_SM); LAS float* dkv = segtot + 640;
    bf16_t* UT = (bf16_t*)(p.ws + WS_S4); float* DK = (float*)(p.ws + M_DK);
    h16x8 plf[2]; u32x4 pvv[2];
#define HG_ISSUE(it_) do { const int _ci = (it_) >> 3, _h = (it_) & 7; _Pragma("unroll") for (int i = 0; i < 2; ++i) { const int v = tid + 512 * i, t = v >> 4, c8 = (v & 15) * 8; \
        const size_t e = ((size_t)(_ci * 64 + t) * DM + _h * 128 + c8) * 2; plf[i] = *(const h16x8*)(p.ws + WS_S1 + e); pvv[i] = *(const u32x4*)(p.ws + WS_S2 + e); } } while (0)
#define HG_COMMIT() do { _Pragma("unroll") for (int i = 0; i < 2; ++i) { const int v = tid + 512 * i, t = v >> 4, c8 = (v & 15) * 8; \
        *(LAS f32x4*)(BC + t * 128 + c8) = (f32x4){(float)plf[i][0], (float)plf[i][1], (float)plf[i][2], (float)plf[i][3]}; \
        *(LAS f32x4*)(BC + t * 128 + c8 + 4) = (f32x4){(float)plf[i][4], (float)plf[i][5], (float)plf[i][6], (float)plf[i][7]}; \
        *(LAS u32x4*)(VV + t * 136 + c8) = pvv[i]; } } while (0)
    if ((int)blockIdx.x < NITEM) HG_ISSUE((int)blockIdx.x);
    for (int it = blockIdx.x; it < NITEM; it += gridDim.x) {
        const int ci = it >> 3, h = it & 7, row0 = ci * 64;
        HG_COMMIT();
        if (it + (int)gridDim.x < NITEM) HG_ISSUE(it + (int)gridDim.x);
        __syncthreads();
        const int ch = tid & 127, seg = tid >> 7;
        float kk[16], bl[16]; float run = 0.f;
#pragma unroll
        for (int j = 0; j < 16; ++j) { const float lf = BC[(seg * 16 + j) * 128 + ch]; kk[j] = 1.0f - fexp(lf); run += lf; bl[j] = run; }
        segtot[seg * 128 + ch] = run;
        __syncthreads();
        const float s0 = segtot[ch], s1 = segtot[128 + ch], s2 = segtot[256 + ch], s3 = segtot[384 + ch];
        const float blast = (s0 + s1) + (s2 + s3);
        const float off = seg == 0 ? 0.f : seg == 1 ? s0 : seg == 2 ? s0 + s1 : s0 + s1 + s2;
        float kv[16];
#pragma unroll
        for (int j = 0; j < 16; ++j) kv[j] = kk[j] * fexp(blast - (off + bl[j]));
        u32x4 w0, w1; w0.x = pk2(kv[0], kv[1]); w0.y = pk2(kv[2], kv[3]); w0.z = pk2(kv[4], kv[5]); w0.w = pk2(kv[6], kv[7]);
        w1.x = pk2(kv[8], kv[9]); w1.y = pk2(kv[10], kv[11]); w1.z = pk2(kv[12], kv[13]); w1.w = pk2(kv[14], kv[15]);
        *(LAS u32x4*)(KT + ch * 72 + seg * 16) = w0; *(LAS u32x4*)(KT + ch * 72 + seg * 16 + 8) = w1;
        if (seg == 0) { const float dk = fexp(blast); dkv[ch] = dk; if (ci < 256) DK[(size_t)it * 128 + ch] = dk; }
        __syncthreads();
        const int kb = wave;
        bf16x8 a[2];
#pragma unroll
        for (int ss = 0; ss < 2; ++ss) a[ss] = *(const LAS bf16x8*)(KT + (kb * 16 + fr) * 72 + ss * 32 + fq * 8);
        const int k4 = kb * 16 + fq * 4;
        const f32x4 dk4 = *(const LAS f32x4*)(dkv + k4);
#pragma unroll
        for (int vb = 0; vb < 8; ++vb) {
            f32x4 acc = (f32x4){0.f, 0.f, 0.f, 0.f};
#pragma unroll
            for (int ss = 0; ss < 2; ++ss) { const bf16x8 b = tr_frag(VV, 136, ss * 32, vb * 16, lane); acc = __builtin_amdgcn_mfma_f32_16x16x32_bf16(a[ss], b, acc, 0, 0, 0); }
            const int v = vb * 16 + fr;
            bf16_t* ut = UT + (size_t)it * 16384 + v * 128 + k4;
            if (ci < 256) { u32x2 o; o.x = pk2(acc[0], acc[1]); o.y = pk2(acc[2], acc[3]); *(u32x2*)ut = o; }
            else { const int sb = ci - 256; const size_t sbase = ((size_t)(sb * 8 + h) * 128 + k4) * 128 + v; float s[4];
#pragma unroll
                for (int j = 0; j < 4; ++j) { s[j] = p.state_hgrn[sbase + (size_t)j * 128]; p.out[O_HS + sbase + (size_t)j * 128] = dk4[j] * s[j] + acc[j]; }
                u32x2 o; o.x = pk2(s[0], s[1]); o.y = pk2(s[2], s[3]); *(u32x2*)ut = o; }
        }
        __syncthreads();
    }
}

__device__ __forceinline__ void phase_scan(const Params& p) {
    bf16_t* UT = (bf16_t*)(p.ws + WS_S4); const float* DK = (const float*)(p.ws + M_DK);
    for (int gid = blockIdx.x * 512 + opaque_tid(); gid < 32 * 4096; gid += gridDim.x * 512) {
        const int e4 = gid & 4095, bh = gid >> 12, b = bh >> 3, h = bh & 7, v = e4 >> 5, k4 = (e4 & 31) * 4;
        f32x4 S = (f32x4){0.f, 0.f, 0.f, 0.f};
        for (int c0 = 0; c0 < 64; c0 += 8) {
            u32x2 uu[8]; f32x4 dd[8];
#pragma unroll
            for (int i = 0; i < 8; ++i) { const size_t it = (size_t)((b * 64 + c0 + i) * 8 + h); uu[i] = *(const u32x2*)(UT + it * 16384 + e4 * 4); dd[i] = *(const f32x4*)(DK + it * 128 + k4); }
#pragma unroll
            for (int i = 0; i < 8; ++i) { const size_t it = (size_t)((b * 64 + c0 + i) * 8 + h);
                u32x2 o; o.x = pk2(S[0], S[1]); o.y = pk2(S[2], S[3]); *(u32x2*)(UT + it * 16384 + e4 * 4) = o;
                S[0] = dd[i][0] * S[0] + bflo(uu[i].x); S[1] = dd[i][1] * S[1] + bfhi(uu[i].x); S[2] = dd[i][2] * S[2] + bflo(uu[i].y); S[3] = dd[i][3] * S[3] + bfhi(uu[i].y); }
        }
        float* o = p.out + O_HP + ((size_t)(b * 8 + h) * 128 + k4) * 128 + v;
#pragma unroll
        for (int j = 0; j < 4; ++j) o[(size_t)j * 128] = S[j];
    }
}

__device__ __forceinline__ void phase_O(const Params& p, LAS unsigned char* lds) {
    const int tid = opaque_tid(), wave = tid >> 6, lane = tid & 63, fr = lane & 15, fq = lane >> 4;
    LAS float* BC = (LAS float*)(lds + L_BC); LAS bf16_t* QH = (LAS bf16_t*)(lds + L_QH); LAS bf16_t* QT = (LAS bf16_t*)(lds + L_QT);
    LAS bf16_t* KH = (LAS bf16_t*)(lds + L_KH); LAS bf16_t* VV = (LAS bf16_t*)(lds + L_VV); LAS bf16_t* PP = (LAS bf16_t*)(lds + L_PP);
    LAS float* segtot = (LAS float*)(lds + L_SM); LAS float* rvec = segtot + 512; LAS float* OO = (LAS float*)(lds + L_O);
    const bf16_t* ST = (const bf16_t*)(p.ws + WS_S4);
    unsigned char* Q = (unsigned char*)p.out; const unsigned char* G = (const unsigned char*)p.out + A1;
    for (int it = blockIdx.x; it < NITEM; it += gridDim.x) {
        const int ci = it >> 3, h = it & 7, row0 = ci * 64;
        h16x8 lfv[2]; u32x4 vvv[2], qv[2], gv[2]; bf16x8 sf[4][4];
        { const unsigned char* LOGF = p.ws + WS_S1; const unsigned char* V = p.ws + WS_S2;
#pragma unroll
            for (int i = 0; i < 2; ++i) { const int v = tid + 512 * i, t = v >> 4, c8 = (v & 15) * 8; const size_t e = ((size_t)(row0 + t) * DM + h * 128 + c8) * 2;
                lfv[i] = *(const h16x8*)(LOGF + e); vvv[i] = *(const u32x4*)(V + e); qv[i] = *(const u32x4*)(Q + e); }
#pragma unroll
            for (int vi = 0; vi < 4; ++vi)
#pragma unroll
                for (int k = 0; k < 4; ++k) sf[vi][k] = *(const bf16x8*)(ST + (size_t)it * 16384 + (((wave & 1) * 4 + vi) * 16 + fr) * 128 + k * 32 + fq * 8);
            { const int t = tid >> 3, part = tid & 7; const size_t e = ((size_t)(row0 + t) * DM + h * 128 + part * 16) * 2; gv[0] = *(const u32x4*)(G + e); gv[1] = *(const u32x4*)(G + e + 16); }
#pragma unroll
            for (int i = 0; i < 2; ++i) { const int v = tid + 512 * i, t = v >> 4, c8 = (v & 15) * 8;
                *(LAS f32x4*)(BC + t * 128 + c8) = (f32x4){(float)lfv[i][0], (float)lfv[i][1], (float)lfv[i][2], (float)lfv[i][3]};
                *(LAS f32x4*)(BC + t * 128 + c8 + 4) = (f32x4){(float)lfv[i][4], (float)lfv[i][5], (float)lfv[i][6], (float)lfv[i][7]};
                *(LAS u32x4*)(VV + t * 136 + c8) = vvv[i]; } }
        __syncthreads();
        { const int ch = tid & 127, seg = tid >> 7;
            float kk[16], bl[16]; float run = 0.f;
#pragma unroll
            for (int j = 0; j < 16; ++j) { const float lf = BC[(seg * 16 + j) * 128 + ch]; kk[j] = 1.0f - fexp(lf); run += lf; bl[j] = run; }
            segtot[seg * 128 + ch] = run;
            __syncthreads();
            const float s0 = segtot[ch], s1 = segtot[128 + ch], s2 = segtot[256 + ch];
            const float r = s0 + s1;
            const float off = seg == 0 ? 0.f : seg == 1 ? s0 : seg == 2 ? s0 + s1 : s0 + s1 + s2;
#pragma unroll
            for (int j = 0; j < 16; ++j) { const float bc = off + bl[j]; const int t = seg * 16 + j; BC[t * 128 + ch] = bc;
                const float kv = kk[j] * fexp(fminf(r - bc, 80.f)); KH[t * 136 + ch] = (bf16_t)(pk2(kv, 0.f) & 0xffffu); }
            if (seg == 0) rvec[ch] = r;
        }
        __syncthreads();
#pragma unroll
        for (int i = 0; i < 2; ++i) { const int v = tid + 512 * i, t = v >> 4, c8 = (v & 15) * 8; float q[8], qh[8], qt[8];
            unpack8(qv[i], q);
#pragma unroll
            for (int j = 0; j < 8; ++j) { const float bc = BC[t * 128 + c8 + j]; qh[j] = q[j] * fexp(fmaxf(bc - rvec[c8 + j], -80.f)); qt[j] = q[j] * fexp(bc); }
            *(LAS u32x4*)(QH + t * 136 + c8) = pack8(qh); *(LAS u32x4*)(QT + t * 136 + c8) = pack8(qt); }
        __syncthreads();
        const int tb = wave >> 1;
#pragma unroll
        for (int sbi = 0; sbi < 2; ++sbi) { const int sb = (wave & 1) * 2 + sbi; f32x4 acc = (f32x4){0.f, 0.f, 0.f, 0.f};
            if (sb <= tb) {
#pragma unroll
                for (int k = 0; k < 4; ++k) { const bf16x8 a = *(const LAS bf16x8*)(QH + (tb * 16 + fr) * 136 + k * 32 + fq * 8), b = *(const LAS bf16x8*)(KH + (sb * 16 + fr) * 136 + k * 32 + fq * 8);
                    acc = __builtin_amdgcn_mfma_f32_16x16x32_bf16(b, a, acc, 0, 0, 0); }
#pragma unroll
                for (int j = 0; j < 4; ++j) acc[j] = (sb * 16 + fq * 4 + j <= tb * 16 + fr) ? acc[j] : 0.f;
            }
            u32x2 o; o.x = pk2(acc[0], acc[1]); o.y = pk2(acc[2], acc[3]); *(LAS u32x2*)(PP + (tb * 16 + fr) * 72 + sb * 16 + fq * 4) = o; }
        __syncthreads();
        { bf16x8 pa[2], qa[4];
#pragma unroll
            for (int ss = 0; ss < 2; ++ss) pa[ss] = *(const LAS bf16x8*)(PP + (tb * 16 + fr) * 72 + ss * 32 + fq * 8);
#pragma unroll
            for (int k = 0; k < 4; ++k) qa[k] = *(const LAS bf16x8*)(QT + (tb * 16 + fr) * 136 + k * 32 + fq * 8);
#pragma unroll
            for (int vi = 0; vi < 4; ++vi) { const int vb = (wave & 1) * 4 + vi; f32x4 acc = (f32x4){0.f, 0.f, 0.f, 0.f};
#pragma unroll
                for (int ss = 0; ss < 2; ++ss) { const bf16x8 vf = tr_frag(VV, 136, ss * 32, vb * 16, lane); acc = __builtin_amdgcn_mfma_f32_16x16x32_bf16(vf, pa[ss], acc, 0, 0, 0); }
#pragma unroll
                for (int k = 0; k < 4; ++k) acc = __builtin_amdgcn_mfma_f32_16x16x32_bf16(sf[vi][k], qa[k], acc, 0, 0, 0);
                *(LAS f32x4*)(OO + (tb * 16 + fr) * 132 + vb * 16 + fq * 4) = acc; }
        }
        __syncthreads();
        { const int t = tid >> 3, part = tid & 7; float o[16]; float ss = 0.f;
#pragma unroll
            for (int j = 0; j < 4; ++j) { const f32x4 x = *(const LAS f32x4*)(OO + t * 132 + part * 16 + 4 * j); o[4 * j] = x[0]; o[4 * j + 1] = x[1]; o[4 * j + 2] = x[2]; o[4 * j + 3] = x[3]; ss += (x[0] * x[0] + x[1] * x[1]) + (x[2] * x[2] + x[3] * x[3]); }
            ss += __shfl_xor(ss, 1); ss += __shfl_xor(ss, 2); ss += __shfl_xor(ss, 4);
            const float rstd = rsqrtf(ss * (1.0f / 128.f) + EPS);
            const size_t e = ((size_t)(row0 + t) * DM + h * 128 + part * 16) * 2;
#pragma unroll
            for (int hh = 0; hh < 2; ++hh) { float g[8], y[8]; unpack8(gv[hh], g);
#pragma unroll
                for (int j = 0; j < 8; ++j) y[j] = o[hh * 8 + j] * rstd * p.hg_norm[part * 16 + hh * 8 + j] * g[j];
                *(u32x4*)(Q + e + hh * 16) = pack8(y); }
        }
        __syncthreads();
    }
}

__device__ __forceinline__ void phase_final(const Params& p) {
    const int tid_ = opaque_tid(); const int wave = tid_ >> 6, lane = tid_ & 63; const float* rss3 = (const float*)(p.ws + M_RSS) + 3 * MT;
    for (int row = blockIdx.x * 8 + wave; row < MT; row += gridDim.x * 8) {
        const float rs = rsqrtf(rss3[row] * (1.0f / DM) + EPS); float* y = p.out + (size_t)row * DM;
#pragma unroll
        for (int j = 0; j < 4; ++j) { f32x4 v = *(f32x4*)(y + 4 * lane + 256 * j); const f32x4 g = *(const f32x4*)(p.norm_final + 4 * lane + 256 * j);
            v[0] *= rs * g[0]; v[1] *= rs * g[1]; v[2] *= rs * g[2]; v[3] *= rs * g[3]; *(f32x4*)(y + 4 * lane + 256 * j) = v; }
    }
}

#define XB_TMO      128
#define XB_XCNT(j)  (256  + 64 * (j))
#define XB_XSUB(j)  (1280 + 64 * (j))
#define XB_XGEN(j)  (2304 + 64 * (j))
#define XB_TOP      3328
#define XB_TOPGEN   3392
#define XCD_BAR_WORDS 3456
#define XB_SPIN_CAP (1u << 18)
__device__ __forceinline__ unsigned xb_ld(unsigned* p)              { return __hip_atomic_load(p, __ATOMIC_RELAXED, __HIP_MEMORY_SCOPE_AGENT); }
__device__ __forceinline__ unsigned xb_add(unsigned* p, unsigned v) { return __hip_atomic_fetch_add(p, v, __ATOMIC_RELAXED, __HIP_MEMORY_SCOPE_AGENT); }
__device__ __forceinline__ unsigned xb_xcc_id() { return (unsigned)__builtin_amdgcn_s_getreg((3 << 11) | 20) & 0xFu; }
#define XB_SPIN(cond, bar) do { unsigned _sp = 0; while (cond) { __builtin_amdgcn_s_sleep(1); \
    if ((++_sp & 255u) == 0u) { if (xb_ld(&(bar)[XB_TMO])) break; if (_sp > XB_SPIN_CAP) { atomicAdd(&(bar)[XB_TMO], 1u); break; } } } } while (0)
struct XcdBarrier { unsigned* bar; unsigned x; volatile LAS unsigned* st; };
__device__ __forceinline__ XcdBarrier xcd_barrier_post(unsigned* bar, volatile LAS unsigned* st) {
    XcdBarrier b; b.bar = bar; b.x = xb_xcc_id(); b.st = st;
    if (threadIdx.x == 0) st[3] = xb_add(&bar[XB_XCNT(b.x)], 1u);
    return b;
}
__device__ __forceinline__ void xcd_barrier_complete(unsigned* bar, unsigned x, unsigned& nloc, unsigned& nx) {
    const unsigned G = gridDim.x * gridDim.y * gridDim.z;
    unsigned sum, cnt, mine, sp = 0u;
    for (;;) {
        sum = 0u; cnt = 0u; mine = 0u;
#pragma unroll
        for (unsigned j = 0; j < 16; ++j) { const unsigned c = xb_ld(&bar[XB_XCNT(j)]); sum += c; cnt += (c > 0u) ? 1u : 0u; mine = (j == x) ? c : mine; }
        if (sum == G) break;
        __builtin_amdgcn_s_sleep(1);
        if ((++sp & 255u) == 0u) { if (xb_ld(&bar[XB_TMO])) break; if (sp > XB_SPIN_CAP) { atomicAdd(&bar[XB_TMO], 1u); break; } }
    }
    nloc = mine > 0u ? mine : 1u; nx = cnt > 0u ? cnt : 1u;
}
__device__ __forceinline__ void xcd_barrier(const XcdBarrier& b) {
    asm volatile("s_waitcnt vmcnt(0)" ::: "memory");
    __syncthreads();
    if (threadIdx.x == 0) {
        unsigned* bar = b.bar;
        __builtin_amdgcn_s_waitcnt(0);
        unsigned nloc = b.st[0], nx = b.st[1];
        if (nloc == 0u) { xcd_barrier_complete(bar, b.x, nloc, nx); b.st[0] = nloc; b.st[1] = nx; }
        const unsigned old = xb_add(&bar[XB_XSUB(b.x)], 1u);
        const unsigned gen = old / nloc;
        if (old + 1u == (gen + 1u) * nloc) {
            __builtin_amdgcn_fence(__ATOMIC_RELEASE, "agent");
            asm volatile("s_waitcnt vmcnt(0)" ::: "memory");
            const unsigned og = xb_add(&bar[XB_TOP], 1u);
            const unsigned tg = og / nx;
            if (og + 1u == (tg + 1u) * nx) xb_add(&bar[XB_TOPGEN], 1u);
            else XB_SPIN(xb_ld(&bar[XB_TOPGEN]) == tg, bar);
            __builtin_amdgcn_fence(__ATOMIC_ACQUIRE, "agent");
            xb_add(&bar[XB_XGEN(b.x)], 1u);
            asm volatile("s_waitcnt vmcnt(0)" ::: "memory");
        } else {
            XB_SPIN(xb_ld(&bar[XB_XGEN(b.x)]) == gen, bar);
            __builtin_amdgcn_fence(__ATOMIC_ACQUIRE, "agent");
            asm volatile("s_waitcnt vmcnt(0)" ::: "memory");
        }
    }
    __syncthreads();
}

__global__ void __launch_bounds__(512, 2) hgrn2_shortconv_fwd(Params p) {
    extern __shared__ __attribute__((aligned(16))) unsigned char smem[];
    LAS unsigned char* lds = (LAS unsigned char*)smem;
    cg::grid_group grid = cg::this_grid();
    unsigned char* ws = p.ws; unsigned char* outb = (unsigned char*)p.out;
    const int G = gridDim.x, c = blockIdx.x;
    unsigned* cnt = (unsigned*)(ws + M_CNT);

    volatile LAS unsigned* xbw = (volatile LAS unsigned*)(lds + LDS_BYTES - 16);
    if (threadIdx.x == 0) { xbw[0] = 0u; xbw[1] = 0u; xbw[2] = 0u; xbw[3] = 0u; }
    __syncthreads();
    const XcdBarrier xb = xcd_barrier_post((unsigned*)(ws + M_BAR), xbw);
    if (p.ws == nullptr) grid.sync();
#define RUN_STREAM(mode_, lo_, hi_) do { Stream S{ws, outb, mode_, G, (lo_) + c, hi_, 0, 0}; gemm_stream(lds, S, p); } while (0)
    phase_prep(p, lds);
    xcd_barrier(xb);
    int c8 = c, cx = c;
    { unsigned* bar = (unsigned*)(ws + M_BAR); bool ok = (G == 256);
#pragma unroll
        for (int j = 0; j < 16; ++j) { const unsigned n = xb_ld(&bar[XB_XCNT(j)]); ok = ok && (n == (j < 8 ? 32u : 0u)); }
        const unsigned rank = xbw[3], xcc = xb.x;
        if (ok && rank < 32u && xcc < 8u) { c8 = (int)(rank * 8u + xcc); cx = (int)(xcc * 32u + rank); } }
    { Stream S{ws, outb, 0, G, c8, 1904, 0, 0}; gemm_stream(lds, S, p); }
    xcd_barrier(xb);
    phase_conv(p);
    xcd_barrier(xb);
    phase_U(p, lds);
    xcd_barrier(xb);
    phase_scan(p);
    xcd_barrier(xb);
    phase_O(p, lds);
    xcd_barrier(xb);
    { Stream S{ws, outb, 1, G, cx, 560, 0, 0}; gemm_stream(lds, S, p); }
    { Stream S{ws, outb, 1, G, 544 + ((cx + 128) & 255), 1088, 0, 0}; gemm_stream(lds, S, p); }
    xcd_barrier(xb);
    phase_pconv(p, cnt);
    { Stream S{ws, outb, 2, G, cx, 2312, 0, 0}; gemm_stream(lds, S, p); }
    xcd_barrier(xb);
    phase_final(p);
}

extern "C" void kernel_launch(void* const* d_in, const int* in_sizes, int n_in, void* d_out, int out_size, void* d_ws, size_t ws_size, hipStream_t stream) {
    static int grid_blocks = 0;
    if (grid_blocks == 0) {
        if (n_in != 21 || ws_size < WS_NEED) { fprintf(stderr, "kernel_launch: unexpected n_in %d / ws_size %zu (need %zu)\n", n_in, ws_size, (size_t)WS_NEED); grid_blocks = -1; return; }
        int dev = 0, cus = 0, per_cu = 0;
        hipGetDevice(&dev);
        hipDeviceGetAttribute(&cus, hipDeviceAttributeMultiprocessorCount, dev);
        if (hipFuncSetAttribute((const void*)hgrn2_shortconv_fwd, hipFuncAttributeMaxDynamicSharedMemorySize, LDS_BYTES) != hipSuccess) { fprintf(stderr, "kernel_launch: hipFuncSetAttribute failed\n"); grid_blocks = -1; return; }
        if (hipOccupancyMaxActiveBlocksPerMultiprocessor(&per_cu, (const void*)hgrn2_shortconv_fwd, 512, LDS_BYTES) != hipSuccess || per_cu < 1) { fprintf(stderr, "kernel_launch: occupancy query gave %d\n", per_cu); per_cu = 1; }
        (void)hipGetLastError();
        grid_blocks = cus * per_cu;
    }
    if (grid_blocks < 0) return;
    if (hipMemsetAsync((unsigned char*)d_ws + M_BAR, 0, CTL_BYTES, stream) != hipSuccess) { fprintf(stderr, "kernel_launch: memset failed\n"); return; }
    Params p{};
    const float** f = (const float**)&p;
    for (int i = 0; i < 21; ++i) f[i] = (const float*)d_in[i];
    p.out = (float*)d_out; p.ws = (unsigned char*)d_ws;
    void* args[] = {&p};
    hipError_t e = hipLaunchCooperativeKernel((const void*)hgrn2_shortconv_fwd, dim3(grid_blocks), dim3(512), args, LDS_BYTES, stream);
    if (e != hipSuccess) fprintf(stderr, "cooperative launch failed: %s (grid %d)\n", hipGetErrorString(e), grid_blocks);
}
```

```cpp
#include <hip/hip_runtime.h>
#include <hip/hip_cooperative_groups.h>
#include <cstdio>
namespace cg = cooperative_groups;

#define LAS __attribute__((address_space(3)))
#ifndef SEG_MERGE
#define SEG_MERGE 1
#endif
typedef unsigned short bf16_t;
typedef short bf16x8 __attribute__((ext_vector_type(8)));
typedef short s16x4 __attribute__((ext_vector_type(4)));
typedef float f32x4 __attribute__((ext_vector_type(4)));
typedef unsigned u32x4 __attribute__((ext_vector_type(4)));
typedef unsigned u32x2 __attribute__((ext_vector_type(2)));
typedef _Float16 h16x8 __attribute__((ext_vector_type(8)));

constexpr int DM = 1024, MP = 16384, MS = 1024, MT = MP + MS;
constexpr int NIN = 9216, DFF = 2816, PLE = 256;
constexpr int NCHUNK = MT / 64, NITEM = NCHUNK * 8;
constexpr float EPS = 1e-6f;
constexpr size_t A1 = (size_t)MT * DM * 2;

constexpr size_t WS_S0 = 0, WS_S1 = A1, WS_S2 = 2 * A1, WS_S3 = 3 * A1, WS_S4 = 4 * A1, WS_S5 = 5 * A1, WS_S6 = 6 * A1, WS_TAIL = 7 * A1;
constexpr size_t M_RSS = WS_S6;
constexpr size_t M_DK = WS_S6 + 524288;
constexpr size_t M_LB = WS_S6 + 1572864;
constexpr size_t M_BTA = WS_S6 + 2097152, M_BTB = M_BTA + 2097152, M_BTO = M_BTB + 2097152, M_BTPG = M_BTO + 2097152;
constexpr size_t M_BTGU = M_BTPG + 2097152, M_BTD = M_BTGU + (size_t)2 * DFF * DM * 2, M_BTPLE = M_BTD + (size_t)DM * DFF * 2;
constexpr size_t M_BAR = M_BTPLE + (size_t)DM * PLE * 2;
constexpr size_t M_CNT = M_BAR + 16384;
constexpr size_t CTL_BYTES = 16384 + (size_t)6 * 68 * 256;
static_assert(M_BAR + CTL_BYTES <= WS_TAIL, "misc slot overflow");
constexpr size_t WS_NEED = WS_TAIL + (size_t)NIN * DM * 2;

constexpr size_t O_HP = (size_t)MT * DM, O_CP = O_HP + 4 * 8 * 128 * 128, O_HS = O_CP + 4 * 2 * 1024, O_CS = O_HS + (size_t)16 * 8 * 128 * 128;

constexpr int LDS_BYTES = 155648;

struct Params {
    const float *x_prompt, *x_sample, *p_prompt, *p_sample, *state_hgrn, *state_conv, *lower_bounds, *norm_mix, *w_in, *conv_w, *hg_norm,
        *w_a, *w_b, *w_out, *norm_ffn, *w_gu, *w_down, *norm_ple, *w_ple, *w_pg, *norm_final;
    float* out; unsigned char* ws;
};

__device__ __forceinline__ int opaque_tid() { int t = threadIdx.x; asm volatile("" : "+v"(t)); return t; }
typedef float f32x2_ __attribute__((ext_vector_type(2)));
typedef __bf16 bf16x2_ __attribute__((ext_vector_type(2)));
__device__ __forceinline__ unsigned pk2(float lo, float hi) { return __builtin_bit_cast(unsigned, __builtin_convertvector((f32x2_){lo, hi}, bf16x2_)); }
__device__ __forceinline__ float bflo(unsigned u) { return __uint_as_float(u << 16); }
__device__ __forceinline__ float bfhi(unsigned u) { return __uint_as_float(u & 0xffff0000u); }
__device__ __forceinline__ float fexp(float x) { return __builtin_amdgcn_exp2f(x * 1.4426950408889634f); }
__device__ __forceinline__ float flog(float x) { return __builtin_amdgcn_logf(x) * 0.6931471805599453f; }
__device__ __forceinline__ float sigm(float z) { return __builtin_amdgcn_rcpf(1.0f + __builtin_amdgcn_exp2f(z * -1.4426950408889634f)); }
typedef float f32x2 __attribute__((ext_vector_type(2)));
__device__ __forceinline__ f32x2 sigm2(f32x2 acc, float rs_nl2e) { const f32x2 b = acc * rs_nl2e; f32x2 e; e.x = __builtin_amdgcn_exp2f(b.x); e.y = __builtin_amdgcn_exp2f(b.y);
    const f32x2 d = e + 1.0f; f32x2 r; r.x = __builtin_amdgcn_rcpf(d.x); r.y = __builtin_amdgcn_rcpf(d.y); return r; }
__device__ __forceinline__ float wave_sum(float v) {
#pragma unroll
    for (int o = 1; o < 64; o <<= 1) v += __shfl_xor(v, o);
    return v;
}
__device__ __forceinline__ void unpack8(const u32x4 w, float (&f)[8]) {
    f[0] = bflo(w.x); f[1] = bfhi(w.x); f[2] = bflo(w.y); f[3] = bfhi(w.y); f[4] = bflo(w.z); f[5] = bfhi(w.z); f[6] = bflo(w.w); f[7] = bfhi(w.w);
}
__device__ __forceinline__ u32x4 pack8(const float (&f)[8]) { u32x4 w; w.x = pk2(f[0], f[1]); w.y = pk2(f[2], f[3]); w.z = pk2(f[4], f[5]); w.w = pk2(f[6], f[7]); return w; }

constexpr int BM = 256, BK = 64, HALF = 128, HTB = HALF * BK * 2, NXCD = 8, WGM = 8;
__device__ __forceinline__ int lds_byte(int r, int c) { const int st = (r >> 4) * 2 + (c >> 5), rr = r & 15, cc = c & 31, ob = rr * 64 + cc * 2; return st * 1024 + (ob ^ (((ob >> 9) & 1) << 5)); }
__device__ __forceinline__ void stage_rc(int b, int& R, int& C) { const int st = b / 1024, sb = b % 1024, swz = sb ^ (((sb >> 9) & 1) << 5); R = (st >> 1) * 16 + swz / 64; C = (st & 1) * 32 + (swz % 64) / 2; }
__device__ __forceinline__ int perm32(int rho) { const int n = rho >> 4, i = rho & 15; return 8 * (i >> 2) + 4 * n + (i & 3); }

enum { T_IN = 0, T_BR = 1, T_OUT = 2, T_GU = 3, T_PLE = 4, T_DOWN = 5, T_PG = 6 };
struct Unit { const char* A; const char* B; int pm, pn, part, type; };
__device__ __forceinline__ int unit_K(int type) { return type == T_PLE ? PLE : type == T_DOWN ? DFF : 1024; }
constexpr int CNT_STRIDE = 64;
__device__ __forceinline__ unsigned* cnt_at(unsigned* cnt, int k, int pm) { return cnt + (size_t)(k * 68 + pm) * CNT_STRIDE; }
constexpr size_t TS1024 = (size_t)256 * 1024 * 2;

struct Stream {
    unsigned char* ws; unsigned char* outb; int mode, G, pos, hi, pend, last_t;
    __device__ __forceinline__ void branch(Unit& u, int t, int part) const {
        const int q = t - 544; u.pm = q >> 2; u.pn = q & 3; u.part = part; u.type = T_BR;
        u.A = (const char*)(part ? ws + WS_S3 : outb) + (size_t)u.pm * TS1024; u.B = (const char*)(ws + (part ? M_BTB : M_BTA)) + (size_t)u.pn * TS1024;
    }
    __device__ __forceinline__ bool next(Unit& u) {
        if (mode == 0) {
            constexpr int nN = 28, nM = MT / 256, nwg = nM * nN; if (pos >= hi) return false;
            int wgid = pos; pos += G;
            { const int q = nwg / NXCD, r = nwg % NXCD, xcd = wgid % NXCD, off = wgid / NXCD; wgid = (xcd < r ? xcd * (q + 1) : r * (q + 1) + (xcd - r) * q) + off; }
            const int nig = WGM * nN, gid = wgid / nig, fm = gid * WGM, gsz = (nM - fm) < WGM ? (nM - fm) : WGM;
            u.pm = fm + ((wgid % nig) % gsz); u.pn = (wgid % nig) / gsz; u.part = 1; u.type = T_IN;
            u.A = (const char*)(ws + WS_S0) + (size_t)u.pm * TS1024; u.B = (const char*)(ws + WS_TAIL) + (size_t)u.pn * TS1024; return true;
        }
        if (mode == 1) {
            if (pend) { pend = 0; branch(u, last_t, 1); return true; }
            if (hi == 560) {
                int pp = pos; pos += G; if (pp >= 384 && pp < 400) { pp = pos; pos += G; }
                if (pp >= 560) return false;
                const int t = pp < 384 ? pp : pp - 16;
                u.pm = t >> 3; u.pn = 28 + (t & 7); u.part = 1; u.type = T_IN; u.A = (const char*)(ws + WS_S0) + (size_t)u.pm * TS1024; u.B = (const char*)(ws + WS_TAIL) + (size_t)u.pn * TS1024; return true;
            }
            const int t = pos; if (t >= hi) return false; pos += G;
            if (t < 544) { u.pm = t >> 3; u.pn = 28 + (t & 7); u.part = 1; u.type = T_IN; u.A = (const char*)(ws + WS_S0) + (size_t)u.pm * TS1024; u.B = (const char*)(ws + WS_TAIL) + (size_t)u.pn * TS1024; return true; }
            if (t < 816) { branch(u, t, 0); pend = 1; last_t = t; return true; }
            const int q = t - 816; u.pm = q >> 2; u.pn = q & 3; u.part = 1; u.type = T_OUT; u.A = (const char*)(ws + WS_S1) + (size_t)u.pm * TS1024; u.B = (const char*)(ws + M_BTO) + (size_t)u.pn * TS1024; return true;
        }
        int pp = pos; pos += G;
        while (pp < 1528 && ((pp >= 8 && pp < 24) || (pp >= 264 && pp < 280))) { pp = pos; pos += G; }
        if (pp >= 2344) return false;
        u.part = 1;
        if (pp < 1528) { const int t = pp < 8 ? pp : (pp < 264 ? pp - 16 : pp - 32); u.pm = t / 22; u.pn = t % 22; u.type = T_GU; u.A = (const char*)(ws + WS_S3) + (size_t)u.pm * TS1024; u.B = (const char*)(ws + M_BTGU) + (size_t)u.pn * TS1024; return true; }
        if (pp < 1800) { const int q = pp - 1528; u.pm = q >> 2; u.pn = q & 3; u.type = T_PLE; u.A = (const char*)(ws + WS_TAIL) + (size_t)u.pm * 256 * PLE * 2; u.B = (const char*)(ws + M_BTPLE) + (size_t)u.pn * 256 * PLE * 2; return true; }
        if (pp < 2072) { const int q = pp - 1800; u.pm = q >> 2; u.pn = q & 3; u.type = T_DOWN; u.A = (const char*)(ws + WS_S0) + (size_t)u.pm * 256 * DFF * 2; u.B = (const char*)(ws + M_BTD) + (size_t)u.pn * 256 * DFF * 2; return true; }
        const int q = pp - 2072; u.pm = q >> 2; u.pn = q & 3; u.type = T_PG; u.A = (const char*)(ws + WS_S3) + (size_t)u.pm * TS1024; u.B = (const char*)(ws + M_BTPG) + (size_t)u.pn * TS1024; return true;
    }
};

typedef f32x4 Acc[2][2][4][2];

template <bool WT, bool FORCE = false> __device__ __forceinline__ void st16(void* ptr, u32x4 v) {
    if (WT && !FORCE) asm volatile("global_store_dwordx4 %0, %1, off sc1\n\ts_nop 1" :: "v"(ptr), "v"(v) : "memory"); else *(u32x4*)ptr = v;
}
template <bool WT> __device__ __forceinline__ void st16f(void* ptr, f32x4 v) { st16<WT>(ptr, __builtin_bit_cast(u32x4, v)); }

#define EPI_ROWS for (int ai = 0; ai < 2; ++ai) _Pragma("unroll") for (int m = 0; m < 4; ++m)
#define EPI_ROW (u.pm * 256 + ai * 128 + wr * 64 + m * 16 + fr)
#define EPI_COLT(bj) ((bj) * 128 + wc * 32 + 8 * fq)

template <int ACT> __device__ __forceinline__ void epi_in_body(const Acc& acc, const Unit& u, int wr, int wc, int fr, int fq, const float* rss0, const float* lbv, unsigned char* base, int scol, float scale) {
#pragma unroll
    EPI_ROWS { const int row = EPI_ROW; const float rs = rsqrtf(rss0[row] * (1.0f / DM) + EPS);
#pragma unroll
        for (int bj = 0; bj < 2; ++bj) { const int col = scol + EPI_COLT(bj); float v[8];
            if (ACT == 0 || ACT == 3) {
                const float rsn = rs * -1.4426950408889634f, rss_ = rs * scale;
#pragma unroll
                for (int n = 0; n < 2; ++n)
#pragma unroll
                    for (int j = 0; j < 4; j += 2) { const f32x2 a2 = (f32x2){acc[ai][bj][m][n][j], acc[ai][bj][m][n][j + 1]}; const f32x2 r2 = sigm2(a2, rsn);
                        const f32x2 o2 = ACT == 0 ? (a2 * rss_) * r2 : r2; v[4 * n + j] = o2.x; v[4 * n + j + 1] = o2.y; }
                if (ACT == 3) { st16<true>(base + ((size_t)row * DM + col) * 2, pack8(v)); continue; }
                *(u32x4*)(base + ((size_t)row * DM + col) * 2) = pack8(v); continue;
            }
#pragma unroll
            for (int j = 0; j < 4; ++j) { v[j] = acc[ai][bj][m][0][j] * rs; v[4 + j] = acc[ai][bj][m][1][j] * rs; }
            if (ACT == 1) {
                const f32x4 l0 = *(const f32x4*)(lbv + col), l1 = *(const f32x4*)(lbv + col + 4);
                const float lb[8] = {l0[0], l0[1], l0[2], l0[3], l1[0], l1[1], l1[2], l1[3]};
                float lf[8];
#pragma unroll
                for (int j = 0; j < 8; ++j) { const float e = fexp(-v[j]); lf[j] = flog((1.0f + lb[j] * e) * __builtin_amdgcn_rcpf(1.0f + e)); }
                u32x4 w;
                w.x = __builtin_bit_cast(unsigned, __builtin_amdgcn_cvt_pkrtz(lf[0], lf[1])); w.y = __builtin_bit_cast(unsigned, __builtin_amdgcn_cvt_pkrtz(lf[2], lf[3]));
                w.z = __builtin_bit_cast(unsigned, __builtin_amdgcn_cvt_pkrtz(lf[4], lf[5])); w.w = __builtin_bit_cast(unsigned, __builtin_amdgcn_cvt_pkrtz(lf[6], lf[7]));
                *(u32x4*)(base + ((size_t)row * DM + col) * 2) = w; continue;
            }
            *(u32x4*)(base + ((size_t)row * DM + col) * 2) = pack8(v); } }
}
__device__ __forceinline__ void epi_in(const Acc& acc, const Unit& u, int wr, int wc, int fr, int fq, const Params& p) {
    unsigned char* ws = p.ws; unsigned char* outb = (unsigned char*)p.out;
    const float* rss0 = (const float*)(ws + M_RSS); const float* lbv = (const float*)(ws + M_LB);
    const int sec = u.pn >> 2, scol = (u.pn & 3) * 256;
    unsigned char* base = sec == 0 ? outb : sec == 1 ? ws + WS_S1 : sec == 2 ? ws + WS_S2 : sec == 3 ? outb + A1 : sec == 4 ? ws + WS_S3 : sec == 5 ? ws + WS_S4 : sec == 6 ? ws + WS_S5 : sec == 7 ? ws + WS_S1 : ws + WS_S2;
    if (sec == 0) epi_in_body<0>(acc, u, wr, wc, fr, fq, rss0, lbv, base, scol, 0.08838834764831845f);
    else if (sec == 1) epi_in_body<1>(acc, u, wr, wc, fr, fq, rss0, lbv, base, scol, 1.f);
    else if (sec == 3) epi_in_body<0>(acc, u, wr, wc, fr, fq, rss0, lbv, base, scol, 1.f);
    else if (sec >= 7) epi_in_body<3>(acc, u, wr, wc, fr, fq, rss0, lbv, base, scol, 1.f);
    else epi_in_body<2>(acc, u, wr, wc, fr, fq, rss0, lbv, base, scol, 1.f);
}
__device__ __forceinline__ void epi_br(const Acc& acc, const Unit& u, int wr, int wc, int fr, int fq, const Params& p) {
    unsigned char* SA = p.ws + WS_S1; const unsigned char* SB = p.ws + WS_S2; unsigned char* TT = (unsigned char*)p.out + A1;
#pragma unroll
    EPI_ROWS { const int row = EPI_ROW;
#pragma unroll
        for (int bj = 0; bj < 2; ++bj) { const size_t e = ((size_t)row * DM + u.pn * 256 + EPI_COLT(bj)) * 2; float g[8], v[8];
            if (u.part == 0) { unpack8(*(const u32x4*)(SA + e), g);
#pragma unroll
                for (int j = 0; j < 4; ++j) { v[j] = acc[ai][bj][m][0][j] * g[j]; v[4 + j] = acc[ai][bj][m][1][j] * g[4 + j]; }
            } else { unpack8(*(const u32x4*)(SB + e), g);
                float t[8]; unpack8(*(const u32x4*)(TT + e), t);
#pragma unroll
                for (int j = 0; j < 4; ++j) { v[j] = t[j] + acc[ai][bj][m][0][j] * g[j]; v[4 + j] = t[4 + j] + acc[ai][bj][m][1][j] * g[4 + j]; }
            }
            if (u.part == 0) st16<true, true>(TT + e, pack8(v)); else st16<true>(SA + e, pack8(v)); } }
}
template <bool WT> __device__ __forceinline__ void epi_res(const Acc& acc, const Unit& u, int wr, int wc, int fr, int fq, const float* xi_p, const float* xi_s, float* xo, unsigned char* xob, float* rss) {
#pragma unroll
    EPI_ROWS { const int row = EPI_ROW; float part = 0.f;
        const float* xr = row < MP ? xi_p + (size_t)row * DM : xi_s + (size_t)(row - MP) * DM;
#pragma unroll
        for (int bj = 0; bj < 2; ++bj) { const int col = u.pn * 256 + EPI_COLT(bj);
            const f32x4 x0 = *(const f32x4*)(xr + col), x1 = *(const f32x4*)(xr + col + 4);
            const f32x4 y0 = x0 + acc[ai][bj][m][0], y1 = x1 + acc[ai][bj][m][1];
            st16f<WT>(xo + (size_t)row * DM + col, y0); st16f<WT>(xo + (size_t)row * DM + col + 4, y1);
            float v[8] = {y0[0], y0[1], y0[2], y0[3], y1[0], y1[1], y1[2], y1[3]};
#pragma unroll
            for (int j = 0; j < 8; ++j) part += v[j] * v[j];
            st16<WT>(xob + ((size_t)row * DM + col) * 2, pack8(v)); }
        part += __shfl_xor(part, 16); part += __shfl_xor(part, 32);
        if (fq == 0) atomicAdd(rss + row, part); }
}
__device__ __forceinline__ void epi_gu(const Acc& acc, const Unit& u, int wr, int wc, int fr, int fq, const float* rss, unsigned char* H) {
#pragma unroll
    EPI_ROWS { const int row = EPI_ROW; const float rs = rsqrtf(rss[row] * (1.0f / DM) + EPS); float v[8];
#pragma unroll
        for (int n = 0; n < 2; ++n)
#pragma unroll
            for (int j = 0; j < 4; j += 2) { const f32x2 g2 = (f32x2){acc[ai][0][m][n][j], acc[ai][0][m][n][j + 1]}, u2 = (f32x2){acc[ai][1][m][n][j], acc[ai][1][m][n][j + 1]};
                const f32x2 o2 = ((g2 * rs) * sigm2(g2, rs * -1.4426950408889634f)) * (u2 * rs); v[4 * n + j] = o2.x; v[4 * n + j + 1] = o2.y; }
        st16<true>(H + ((size_t)row * DFF + u.pn * 128 + wc * 32 + 8 * fq) * 2, pack8(v)); }
}
__device__ __forceinline__ void epi_ple(const Acc& acc, const Unit& u, int wr, int wc, int fr, int fq, float* U) {
#pragma unroll
    EPI_ROWS { const int row = EPI_ROW;
#pragma unroll
        for (int bj = 0; bj < 2; ++bj) { float* d = U + (size_t)row * DM + u.pn * 256 + EPI_COLT(bj); st16f<true>(d, acc[ai][bj][m][0]); st16f<true>(d + 4, acc[ai][bj][m][1]); } }
}
__device__ __forceinline__ void epi_pg(const Acc& acc, const Unit& u, int wr, int wc, int fr, int fq, const float* rss2, const float* x2, float* uo, float* rss3) {
#pragma unroll
    EPI_ROWS { const int row = EPI_ROW; const float rs = rsqrtf(rss2[row] * (1.0f / DM) + EPS); float part = 0.f;
#pragma unroll
        for (int bj = 0; bj < 2; ++bj) { const size_t e = (size_t)row * DM + u.pn * 256 + EPI_COLT(bj);
#pragma unroll
            for (int n = 0; n < 2; ++n) { const f32x4 xx = *(const f32x4*)(x2 + e + 4 * n), uu = *(const f32x4*)(uo + e + 4 * n); f32x4 y;
#pragma unroll
                for (int j = 0; j < 4; ++j) { y[j] = xx[j] + sigm(acc[ai][bj][m][n][j] * rs) * uu[j]; part += y[j] * y[j]; }
                *(f32x4*)(uo + e + 4 * n) = y; } }
        part += __shfl_xor(part, 16); part += __shfl_xor(part, 32);
        if (fq == 0) atomicAdd(rss3 + row, part); }
}
__device__ __forceinline__ bool epi_dispatch(Acc& acc, const Unit& u, int wr, int wc, int fr, int fq, const Params& p) {
    asm volatile("" : "+v"(fr), "+v"(fq));
    asm volatile("" : "+s"(wr), "+s"(wc));
    unsigned char* ws = p.ws; unsigned char* outb = (unsigned char*)p.out; float* rss = (float*)(ws + M_RSS);
    switch (u.type) {
    case T_IN: epi_in(acc, u, wr, wc, fr, fq, p); return false;
    case T_BR: epi_br(acc, u, wr, wc, fr, fq, p); return false;
    case T_OUT: epi_res<false>(acc, u, wr, wc, fr, fq, p.x_prompt, p.x_sample, (float*)(ws + WS_S4), ws + WS_S3, rss + MT); return false;
    case T_GU: epi_gu(acc, u, wr, wc, fr, fq, rss + MT, ws + WS_S0); return false;
    case T_PLE: epi_ple(acc, u, wr, wc, fr, fq, p.out); return false;
    case T_DOWN: epi_res<true>(acc, u, wr, wc, fr, fq, (const float*)(ws + WS_S4), (const float*)(ws + WS_S4) + (size_t)MP * DM, (float*)(ws + WS_S4), ws + WS_S3, rss + 2 * MT); return false;
    default: epi_pg(acc, u, wr, wc, fr, fq, rss + 2 * MT, (const float*)(ws + WS_S4), p.out, rss + 3 * MT); return false;
    }
}

__device__ __forceinline__ void poll_ge(unsigned* w, unsigned need) {
    unsigned spins = 0;
    while ((unsigned)__builtin_amdgcn_readfirstlane(__hip_atomic_load(w, __ATOMIC_RELAXED, __HIP_MEMORY_SCOPE_AGENT)) < need) { __builtin_amdgcn_s_sleep(2); if (++spins > (1u << 21)) break; }
}
__device__ __forceinline__ void unit_ready(const Unit& u, unsigned* cnt) {
    const int ty = u.type;
    if (ty == T_IN || ty == T_GU || (ty == T_BR && u.part != 0)) return;
    if (threadIdx.x < 64) {
        if (ty == T_BR) poll_ge(cnt_at(cnt, 0, u.pm), 64u);
        else if (ty == T_OUT) poll_ge(cnt_at(cnt, 1, u.pm), 32u);
        else if (ty == T_PLE) poll_ge(cnt_at(cnt, 5, 0), gridDim.x);
        else if (ty == T_DOWN) poll_ge(cnt_at(cnt, 2, u.pm), 176u);
        else { poll_ge(cnt_at(cnt, 3, u.pm), 32u); poll_ge(cnt_at(cnt, 4, u.pm), 32u); }
        __builtin_amdgcn_fence(__ATOMIC_ACQUIRE, "agent");
        asm volatile("s_waitcnt vmcnt(0)" ::: "memory");
    }
    asm volatile("" ::: "memory"); __builtin_amdgcn_s_barrier(); asm volatile("" ::: "memory");
}
__device__ __forceinline__ void unit_done(const Unit& u, unsigned* cnt, LAS unsigned* larr) {
    const int ty = u.type; int k;
    if (ty == T_IN) { if (u.pn < 28) return; k = 0; } else if (ty == T_BR) { if (u.part == 0) { asm volatile("s_waitcnt vmcnt(0)" ::: "memory"); return; } k = 1; }
    else if (ty == T_GU) k = 2; else if (ty == T_DOWN) k = 3; else if (ty == T_PLE) k = 4; else return;
    asm volatile("s_waitcnt vmcnt(0)" ::: "memory");
    if ((threadIdx.x & 63) == 0) __hip_atomic_fetch_add(cnt_at(cnt, k, u.pm), 1u, __ATOMIC_RELAXED, __HIP_MEMORY_SCOPE_AGENT);
}

__device__ __forceinline__ void gemm_stream(LAS unsigned char* lds, Stream& S, const Params& p) {
    const int tid = opaque_tid(), wid = __builtin_amdgcn_readfirstlane(tid >> 6), lane = tid & 63, wr = wid >> 2, wc = wid & 3, fr = lane & 15, fq = lane >> 4;
    int R0, C0; stage_rc(tid * 16, R0, C0); const unsigned rA2 = (unsigned)R0 * 2u, rB2 = (unsigned)((R0 & ~31) + perm32(R0 & 31)) * 2u, c2 = (unsigned)C0 * 2u;
    const size_t kstep = (size_t)(BK * 2);
    const unsigned ldsw = (unsigned)wid * 1024u;
    const int aoff = lds_byte(wr * 64 + fr, fq * 8), boff = lds_byte(wc * 32 + fr, fq * 8);
#define PG8_SA(b, h) (((b) * 2 + (h)) * HTB)
#define PG8_SB(b, h) ((4 + (b) * 2 + (h)) * HTB)
#define PG8_STAGE(bufoff, gbase, r2, Kk) do { const unsigned _vo = (r2) * (unsigned)(Kk) + c2; _Pragma("unroll") for (int _i = 0; _i < 2; ++_i) \
        __builtin_amdgcn_global_load_lds((const unsigned*)((const char*)(gbase) + (size_t)_i * ((size_t)128 * (Kk)) + _vo), (LAS unsigned*)(lds + (bufoff) + ldsw + _i * 8192), 16, 0, 0); } while (0)
#define PG8_LDA(dst, b, h) do { _Pragma("unroll") for (int m = 0; m < 4; ++m) _Pragma("unroll") for (int k = 0; k < 2; ++k) dst[m][k] = *(const LAS bf16x8*)(lds + PG8_SA(b, h) + aoff + m * 2048 + k * 1024); } while (0)
#define PG8_LDB(dst, b, h) do { _Pragma("unroll") for (int n = 0; n < 2; ++n) _Pragma("unroll") for (int k = 0; k < 2; ++k) dst[n][k] = *(const LAS bf16x8*)(lds + PG8_SB(b, h) + boff + n * 2048 + k * 1024); } while (0)
#define PG8_MMA(ai, bj, At, Bt) do { __builtin_amdgcn_s_setprio(1); _Pragma("unroll") for (int m = 0; m < 4; ++m) _Pragma("unroll") for (int n = 0; n < 2; ++n) _Pragma("unroll") for (int k = 0; k < 2; ++k) \
        acc[ai][bj][m][n] = __builtin_amdgcn_mfma_f32_16x16x32_bf16(Bt[n][k], At[m][k], acc[ai][bj][m][n], 0, 0, 0); __builtin_amdgcn_s_setprio(0); } while (0)
#define PG8_WAIT_V(n) asm volatile("s_waitcnt vmcnt(" #n ")" ::: "memory")
#define PG8_WAIT_L(n) asm volatile("s_waitcnt lgkmcnt(" #n ")" ::: "memory")
#define PG8_BAR __builtin_amdgcn_s_barrier()
#define PG8_SCHED __builtin_amdgcn_sched_barrier(0)
    Unit cur, nxt;
    bool have = S.next(cur);
    unsigned* cnt = (unsigned*)(p.ws + M_CNT);
    Acc acc;
#pragma unroll
    for (int a = 0; a < 2; ++a)
#pragma unroll
        for (int b = 0; b < 2; ++b)
#pragma unroll
            for (int m = 0; m < 4; ++m)
#pragma unroll
                for (int n = 0; n < 2; ++n) acc[a][b][m][n] = (f32x4){0.f, 0.f, 0.f, 0.f};
    bf16x8 At[4][2], B0[2][2], B1[2][2];
    while (have) {
        const char* cA = cur.A; const char* cB = cur.B;
        int cK = unit_K(cur.type); unsigned hsc = (unsigned)HALF * cK * 2;
        if (SEG_MERGE) unit_ready(cur, cnt);
        PG8_STAGE(PG8_SB(0, 0), cB, rB2, cK); PG8_STAGE(PG8_SA(0, 0), cA, rA2, cK); PG8_STAGE(PG8_SB(0, 1), cB + hsc, rB2, cK); PG8_STAGE(PG8_SA(0, 1), cA + hsc, rA2, cK);
        if (wr == 1) PG8_BAR;
        PG8_WAIT_V(4); PG8_BAR;
        PG8_STAGE(PG8_SB(1, 0), cB + kstep, rB2, cK); PG8_STAGE(PG8_SA(1, 0), cA + kstep, rA2, cK); PG8_STAGE(PG8_SB(1, 1), cB + hsc + kstep, rB2, cK);
        PG8_WAIT_V(6); PG8_BAR;
        for (;;) {
            const bool has_next = S.next(nxt);
            const bool chain = has_next && !(nxt.type == T_OUT || nxt.type == T_PG);
            const char* nA = chain ? nxt.A : cA; const char* nB = chain ? nxt.B : cB; const int nK = chain ? unit_K(nxt.type) : cK;
            const unsigned hsn = (unsigned)HALF * nK * 2;
            const int nt = cK / BK;
            for (int t = 0; t < nt; t += 2) {
                const bool last = (t == nt - 2);
                const char* a1 = cA + (size_t)(t + 1) * kstep;
                const char* a2 = last ? nA : cA + (size_t)(t + 2) * kstep; const char* b2 = last ? nB : cB + (size_t)(t + 2) * kstep;
                const char* a3 = a2 + kstep; const char* b3 = b2 + kstep;
                const int K2 = last ? nK : cK; const unsigned hs2 = last ? hsn : hsc;
                if (SEG_MERGE && last && chain) unit_ready(nxt, cnt);
                PG8_LDB(B0, 0, 0); PG8_SCHED; PG8_LDA(At, 0, 0); PG8_STAGE(PG8_SA(1, 1), a1 + hsc, rA2, cK);
                PG8_WAIT_L(8); PG8_BAR; PG8_WAIT_L(0); PG8_MMA(0, 0, At, B0); PG8_BAR; PG8_SCHED;
                PG8_LDB(B1, 0, 1); PG8_STAGE(PG8_SB(0, 0), b2, rB2, K2);
                PG8_BAR; PG8_WAIT_L(0); PG8_MMA(0, 1, At, B1); PG8_BAR;
                PG8_LDA(At, 0, 1); PG8_STAGE(PG8_SA(0, 0), a2, rA2, K2);
                PG8_BAR; PG8_WAIT_L(0); PG8_MMA(1, 0, At, B0); PG8_BAR; PG8_SCHED;
                PG8_STAGE(PG8_SB(0, 1), b2 + hs2, rB2, K2);
                PG8_WAIT_V(6); PG8_BAR; PG8_MMA(1, 1, At, B1); PG8_BAR;
                PG8_LDB(B0, 1, 0); PG8_SCHED; PG8_LDA(At, 1, 0); PG8_STAGE(PG8_SA(0, 1), a2 + hs2, rA2, K2);
                PG8_WAIT_L(8); PG8_BAR; PG8_WAIT_L(0); PG8_MMA(0, 0, At, B0); PG8_BAR; PG8_SCHED;
                PG8_LDB(B1, 1, 1); PG8_STAGE(PG8_SB(1, 0), b3, rB2, K2);
                PG8_BAR; PG8_WAIT_L(0); PG8_MMA(0, 1, At, B1); PG8_BAR;
                PG8_LDA(At, 1, 1); PG8_STAGE(PG8_SA(1, 0), a3, rA2, K2);
                PG8_BAR; PG8_WAIT_L(0); PG8_MMA(1, 0, At, B0); PG8_BAR; PG8_SCHED;
                PG8_STAGE(PG8_SB(1, 1), b3 + hs2, rB2, K2);
                PG8_WAIT_V(6); PG8_BAR; PG8_MMA(1, 1, At, B1); PG8_BAR;
            }
            (void)epi_dispatch(acc, cur, wr, wc, fr, fq, p);
            if (SEG_MERGE) unit_done(cur, cnt, (LAS unsigned*)(lds + LDS_BYTES - 8));
#pragma unroll
            for (int a = 0; a < 2; ++a)
#pragma unroll
                for (int b = 0; b < 2; ++b)
#pragma unroll
                    for (int m = 0; m < 4; ++m)
#pragma unroll
                        for (int n = 0; n < 2; ++n) acc[a][b][m][n] = (f32x4){0.f, 0.f, 0.f, 0.f};
            have = has_next;
            if (!has_next) break;
            cur = nxt;
            if (!chain) break;
            cA = nA; cB = nB; cK = nK; hsc = hsn;
        }
        PG8_WAIT_V(0);
        if (wr == 0) PG8_BAR;
        PG8_BAR;
    }
#undef PG8_SA
#undef PG8_SB
#undef PG8_STAGE
#undef PG8_LDA
#undef PG8_LDB
#undef PG8_MMA
#undef PG8_WAIT_V
#undef PG8_WAIT_L
#undef PG8_BAR
#undef PG8_SCHED
}

__device__ __forceinline__ void transpose_item(const float* W, int K, int N, int k0, int srccol0, const float* gain, bf16_t* WT, int dstrow0, LAS float* scr, int lane) {
    float w[32], g[32];
    const float* src = W + (size_t)(k0 + (lane >> 5)) * N + srccol0 + (lane & 31);
#pragma unroll
    for (int i = 0; i < 32; ++i) w[i] = src[(size_t)(2 * i) * N];
    if (gain) {
#pragma unroll
        for (int i = 0; i < 32; ++i) g[i] = gain[k0 + 2 * i + (lane >> 5)];
#pragma unroll
        for (int i = 0; i < 32; ++i) w[i] *= g[i];
    }
#pragma unroll
    for (int i = 0; i < 32; ++i) scr[(2 * i + (lane >> 5)) * 33 + (lane & 31)] = w[i];
    asm volatile("s_waitcnt lgkmcnt(0)" ::: "memory");
    const int c = lane & 7;
#pragma unroll
    for (int j = 0; j < 4; ++j) { const int n = (lane >> 3) + 8 * j; const LAS float* s = scr + (8 * c) * 33 + n;
        u32x4 o; o.x = pk2(s[0 * 33], s[1 * 33]); o.y = pk2(s[2 * 33], s[3 * 33]); o.z = pk2(s[4 * 33], s[5 * 33]); o.w = pk2(s[6 * 33], s[7 * 33]);
        *(u32x4*)(WT + (size_t)(dstrow0 + n) * K + k0 + 8 * c) = o; }
    asm volatile("s_waitcnt lgkmcnt(0)" ::: "memory");
}
__device__ __forceinline__ void prep_items(const Params& p, LAS unsigned char* lds, int first, int last, int gw, int NGW) {
    const int tid = opaque_tid(), wave = tid >> 6, lane = tid & 63;
    unsigned char* ws = p.ws;
    LAS float* scr = (LAS float*)(lds + wave * 8448);
    constexpr int I_IN = 16 * (NIN / 32), I_SQ = 16 * 32, I_GU = 16 * (2 * DFF / 32), I_D = (DFF / 64) * 32;
    for (int it = first + gw; it < last; it += NGW) {
        int r = it;
        if (r < I_IN) { const int nb = r % (NIN / 32), kb = r / (NIN / 32); transpose_item(p.w_in, DM, NIN, kb * 64, nb * 32, p.norm_mix, (bf16_t*)(ws + WS_TAIL), nb * 32, scr, lane); continue; } r -= I_IN;
        if (r < 4 * I_SQ) { const int w = r / I_SQ, q = r % I_SQ, nb = q % 32, kb = q / 32;
            const float* W = w == 0 ? p.w_a : w == 1 ? p.w_b : w == 2 ? p.w_out : p.w_pg; const float* g = w == 3 ? p.norm_ple : nullptr;
            bf16_t* D = (bf16_t*)(ws + (w == 0 ? M_BTA : w == 1 ? M_BTB : w == 2 ? M_BTO : M_BTPG));
            transpose_item(W, DM, DM, kb * 64, nb * 32, g, D, nb * 32, scr, lane); continue; } r -= 4 * I_SQ;
        if (r < I_GU) { const int nb = r % (2 * DFF / 32), kb = r / (2 * DFF / 32); const int n0 = nb * 32, pn = n0 >> 8, bj = (n0 >> 7) & 1, j0 = n0 & 127;
            transpose_item(p.w_gu, DM, 2 * DFF, kb * 64, bj * DFF + pn * 128 + j0, p.norm_ffn, (bf16_t*)(ws + M_BTGU), n0, scr, lane); continue; } r -= I_GU;
        if (r < I_D) { const int nb = r % 32, kb = r / 32; transpose_item(p.w_down, DFF, DM, kb * 64, nb * 32, nullptr, (bf16_t*)(ws + M_BTD), nb * 32, scr, lane); continue; } r -= I_D;
        { const int nb = r % 32, kb = r / 32; transpose_item(p.w_ple, PLE, DM, kb * 64, nb * 32, nullptr, (bf16_t*)(ws + M_BTPLE), nb * 32, scr, lane); }
    }
}
constexpr int PREP_I_IN = 16 * (NIN / 32), PREP_NIT = PREP_I_IN + 4 * 16 * 32 + 16 * (2 * DFF / 32) + (DFF / 64) * 32 + (PLE / 64) * 32;

__device__ __forceinline__ void phase_prep(const Params& p, LAS unsigned char* lds) {
    const int tid = opaque_tid(), wave = tid >> 6, lane = tid & 63;
    const int gw = blockIdx.x * 8 + wave, NGW = gridDim.x * 8;
    unsigned char* ws = p.ws;
    float* rss = (float*)(ws + M_RSS);
    for (int row0 = gw; row0 < MT; row0 += 2 * NGW) {
        const int row1 = row0 + NGW; const bool has1 = row1 < MT; const int r1 = has1 ? row1 : row0;
        const float* xr0 = row0 < MP ? p.x_prompt + (size_t)row0 * DM : p.x_sample + (size_t)(row0 - MP) * DM;
        const float* xr1 = r1 < MP ? p.x_prompt + (size_t)r1 * DM : p.x_sample + (size_t)(r1 - MP) * DM;
        f32x4 v[8]; float s0 = 0.f, s1 = 0.f;
#pragma unroll
        for (int j = 0; j < 4; ++j) { v[j] = *(const f32x4*)(xr0 + 4 * lane + 256 * j); v[4 + j] = *(const f32x4*)(xr1 + 4 * lane + 256 * j); }
#pragma unroll
        for (int j = 0; j < 4; ++j) { s0 += (v[j][0] * v[j][0] + v[j][1] * v[j][1]) + (v[j][2] * v[j][2] + v[j][3] * v[j][3]); s1 += (v[4 + j][0] * v[4 + j][0] + v[4 + j][1] * v[4 + j][1]) + (v[4 + j][2] * v[4 + j][2] + v[4 + j][3] * v[4 + j][3]); }
        s0 = wave_sum(s0); s1 = wave_sum(s1);
        bf16_t* xb0 = (bf16_t*)(ws + WS_S0) + (size_t)row0 * DM; bf16_t* xb1 = (bf16_t*)(ws + WS_S0) + (size_t)r1 * DM;
#pragma unroll
        for (int j = 0; j < 4; ++j) { u32x2 o; o.x = pk2(v[j][0], v[j][1]); o.y = pk2(v[j][2], v[j][3]); *(u32x2*)(xb0 + 4 * lane + 256 * j) = o; }
        if (has1) {
#pragma unroll
            for (int j = 0; j < 4; ++j) { u32x2 o; o.x = pk2(v[4 + j][0], v[4 + j][1]); o.y = pk2(v[4 + j][2], v[4 + j][3]); *(u32x2*)(xb1 + 4 * lane + 256 * j) = o; }
        }
        if (lane == 0) { rss[row0] = s0; rss[MT + row0] = 0.f; rss[2 * MT + row0] = 0.f; rss[3 * MT + row0] = 0.f;
            if (has1) { rss[row1] = s1; rss[MT + row1] = 0.f; rss[2 * MT + row1] = 0.f; rss[3 * MT + row1] = 0.f; } }
    }
    if (blockIdx.x == 0) { float* lbv = (float*)(ws + M_LB); for (int c = tid; c < 1024; c += 512) lbv[c] = 1.0f / (1.0f + fexp(p.lower_bounds[1024 + c] - p.lower_bounds[c])); }
    prep_items(p, lds, 0, 16 * (NIN / 32), gw, NGW);
}
__device__ __forceinline__ void phase_pconv(const Params& p, unsigned* cnt) {
    const size_t n4 = (size_t)MT * PLE / 4;
    unsigned long long* dst = (unsigned long long*)(p.ws + WS_TAIL);
    for (size_t i = (size_t)blockIdx.x * 512 + opaque_tid(); i < n4; i += (size_t)gridDim.x * 512) {
        const size_t e = i * 4; const float* src = e < (size_t)MP * PLE ? p.p_prompt + e : p.p_sample + (e - (size_t)MP * PLE);
        const f32x4 v = *(const f32x4*)src;
        dst[i] = (unsigned long long)pk2(v[0], v[1]) | ((unsigned long long)pk2(v[2], v[3]) << 32);
    }
    asm volatile("s_waitcnt vmcnt(0)" ::: "memory");
    __syncthreads();
    if (threadIdx.x == 0) { __builtin_amdgcn_fence(__ATOMIC_RELEASE, "agent"); asm volatile("s_waitcnt vmcnt(0)" ::: "memory"); __hip_atomic_fetch_add(cnt_at(cnt, 5, 0), 1u, __ATOMIC_RELAXED, __HIP_MEMORY_SCOPE_AGENT); }
}

__device__ __forceinline__ void phase_conv(const Params& p) {
    unsigned char* ws = p.ws;
    unsigned char* Bg = ws + WS_S3; const unsigned char* Cg = ws + WS_S4; const unsigned char* Hc = ws + WS_S5;
    const int ntask = (MT / 8) * 128;
    for (int task = blockIdx.x * 512 + opaque_tid(); task < ntask; task += gridDim.x * 512) {
        const int run = task >> 7, c0 = (task & 127) * 8, t0 = run * 8;
        const bool prm = t0 < MP; const int tl = prm ? (t0 & 4095) : ((t0 - MP) & 63), T = prm ? 4096 : 64, sq = prm ? (t0 >> 12) : ((t0 - MP) >> 6);
        float w0[8], w1[8], w2[8], u1[8], u2[8];
#pragma unroll
        for (int j = 0; j < 8; ++j) { w0[j] = p.conv_w[c0 + j]; w1[j] = p.conv_w[1024 + c0 + j]; w2[j] = p.conv_w[2048 + c0 + j]; }
        if (tl == 0) {
            if (prm) {
#pragma unroll
                for (int j = 0; j < 8; ++j) { u1[j] = 0.f; u2[j] = 0.f; }
            } else {
#pragma unroll
                for (int j = 0; j < 8; ++j) { u2[j] = p.state_conv[(size_t)(sq * 2 + 0) * 1024 + c0 + j]; u1[j] = p.state_conv[(size_t)(sq * 2 + 1) * 1024 + c0 + j]; }
            }
        } else {
            float a[8], b[8];
            size_t e = ((size_t)(t0 - 1) * DM + c0) * 2; unpack8(*(const u32x4*)(Cg + e), a); unpack8(*(const u32x4*)(Hc + e), b);
#pragma unroll
            for (int j = 0; j < 8; ++j) u1[j] = a[j] * b[j];
            e = ((size_t)(t0 - 2) * DM + c0) * 2; unpack8(*(const u32x4*)(Cg + e), a); unpack8(*(const u32x4*)(Hc + e), b);
#pragma unroll
            for (int j = 0; j < 8; ++j) u2[j] = a[j] * b[j];
        }
#pragma unroll
        for (int r = 0; r < 8; ++r) {
            const size_t e = ((size_t)(t0 + r) * DM + c0) * 2; float a[8], b[8], g[8], u0[8], y[8];
            unpack8(*(const u32x4*)(Cg + e), a); unpack8(*(const u32x4*)(Hc + e), b); unpack8(*(const u32x4*)(Bg + e), g);
#pragma unroll
            for (int j = 0; j < 8; ++j) { u0[j] = a[j] * b[j]; y[j] = g[j] * (w0[j] * u2[j] + w1[j] * u1[j] + w2[j] * u0[j]); u2[j] = u1[j]; u1[j] = u0[j]; }
            *(u32x4*)(Bg + e) = pack8(y);
            const int tt = tl + r;
            if (tt >= T - 2) { float* o = p.out + (prm ? O_CP : O_CS) + (size_t)(sq * 2 + (tt - (T - 2))) * 1024 + c0;
                *(f32x4*)o = (f32x4){u0[0], u0[1], u0[2], u0[3]}; *(f32x4*)(o + 4) = (f32x4){u0[4], u0[5], u0[6], u0[7]}; }
        }
    }
}

constexpr int L_BC = 0;
constexpr int L_QH = 32768;
constexpr int L_QT = L_QH + 17408;
constexpr int L_KH = L_QT + 17408;
constexpr int L_VV = L_KH + 17408;
constexpr int L_PP = L_VV + 17408;
constexpr int L_SM = L_PP + 9216;
constexpr int L_O = L_SM + 3072;
static_assert(L_O + 64 * 132 * 4 <= LDS_BYTES - 16, "LDS");

__device__ __forceinline__ bf16x8 tr_frag(const LAS bf16_t* base, int stride, int s0, int v0, int lane) {
    const int fq = lane >> 4, i = lane & 15, q = i >> 2, pp = i & 3;
    const LAS bf16_t* a = base + (s0 + fq * 8 + q) * stride + v0 + 4 * pp;
    const s16x4 lo = __builtin_amdgcn_ds_read_tr16_b64_v4i16((LAS s16x4*)a);
    const s16x4 hi = __builtin_amdgcn_ds_read_tr16_b64_v4i16((LAS s16x4*)(a + 4 * stride));
    return (bf16x8){lo[0], lo[1], lo[2], lo[3], hi[0], hi[1], hi[2], hi[3]};
}

__device__ __forceinline__ void hg_load(const Params& p, LAS unsigned char* lds, int row0, int h) {
    const int tid = opaque_tid();
    const unsigned char* LOGF = p.ws + WS_S1; const unsigned char* V = p.ws + WS_S2;
    LAS float* BC = (LAS float*)(lds + L_BC); LAS bf16_t* VV = (LAS bf16_t*)(lds + L_VV);
#pragma unroll
    for (int i = 0; i < 2; ++i) { const int v = tid + 512 * i, t = v >> 4, c8 = (v & 15) * 8; const size_t e = ((size_t)(row0 + t) * DM + h * 128 + c8) * 2;
        const h16x8 lf = *(const h16x8*)(LOGF + e); const u32x4 vv = *(const u32x4*)(V + e);
        *(LAS f32x4*)(BC + t * 128 + c8) = (f32x4){(float)lf[0], (float)lf[1], (float)lf[2], (float)lf[3]};
        *(LAS f32x4*)(BC + t * 128 + c8 + 4) = (f32x4){(float)lf[4], (float)lf[5], (float)lf[6], (float)lf[7]};
        *(LAS u32x4*)(VV + t * 136 + c8) = vv; }
}

__device__ __forceinline__ void phase_U(const Params& p, LAS unsigned char* lds) {
    const int tid = opaque_tid(), wave = tid >> 6, lane = tid & 63, fr = lane & 15, fq = lane >> 4;
    LAS float* BC = (LAS float*)(lds + L_BC); LAS bf16_t* KT = (LAS bf16_t*)(lds + L_KH); LAS bf16_t* VV = (LAS bf16_t*)(lds + L_VV);
    LAS float* segtot = (LAS float*)(lds + L_SM); LAS float* dkv = segtot + 640;
    bf16_t* UT = (bf16_t*)(p.ws + WS_S4); float* DK = (float*)(p.ws + M_DK);
    h16x8 plf[2]; u32x4 pvv[2];
#define HG_ISSUE(it_) do { const int _ci = (it_) >> 3, _h = (it_) & 7; _Pragma("unroll") for (int i = 0; i < 2; ++i) { const int v = tid + 512 * i, t = v >> 4, c8 = (v & 15) * 8; \
        const size_t e = ((size_t)(_ci * 64 + t) * DM + _h * 128 + c8) * 2; plf[i] = *(const h16x8*)(p.ws + WS_S1 + e); pvv[i] = *(const u32x4*)(p.ws + WS_S2 + e); } } while (0)
#define HG_COMMIT() do { _Pragma("unroll") for (int i = 0; i < 2; ++i) { const int v = tid + 512 * i, t = v >> 4, c8 = (v & 15) * 8; \
        *(LAS f32x4*)(BC + t * 128 + c8) = (f32x4){(float)plf[i][0], (float)plf[i][1], (float)plf[i][2], (float)plf[i][3]}; \
        *(LAS f32x4*)(BC + t * 128 + c8 + 4) = (f32x4){(float)plf[i][4], (float)plf[i][5], (float)plf[i][6], (float)plf[i][7]}; \
        *(LAS u32x4*)(VV + t * 136 + c8) = pvv[i]; } } while (0)
    if ((int)blockIdx.x < NITEM) HG_ISSUE((int)blockIdx.x);
    for (int it = blockIdx.x; it < NITEM; it += gridDim.x) {
        const int ci = it >> 3, h = it & 7, row0 = ci * 64;
        HG_COMMIT();
        if (it + (int)gridDim.x < NITEM) HG_ISSUE(it + (int)gridDim.x);
        __syncthreads();
        const int ch = tid & 127, seg = tid >> 7;
        float kk[16], bl[16]; float run = 0.f;
#pragma unroll
        for (int j = 0; j < 16; ++j) { const float lf = BC[(seg * 16 + j) * 128 + ch]; kk[j] = 1.0f - fexp(lf); run += lf; bl[j] = run; }
        segtot[seg * 128 + ch] = run;
        __syncthreads();
        const float s0 = segtot[ch], s1 = segtot[128 + ch], s2 = segtot[256 + ch], s3 = segtot[384 + ch];
        const float blast = (s0 + s1) + (s2 + s3);
        const float off = seg == 0 ? 0.f : seg == 1 ? s0 : seg == 2 ? s0 + s1 : s0 + s1 + s2;
        float kv[16];
#pragma unroll
        for (int j = 0; j < 16; ++j) kv[j] = kk[j] * fexp(blast - (off + bl[j]));
        u32x4 w0, w1; w0.x = pk2(kv[0], kv[1]); w0.y = pk2(kv[2], kv[3]); w0.z = pk2(kv[4], kv[5]); w0.w = pk2(kv[6], kv[7]);
        w1.x = pk2(kv[8], kv[9]); w1.y = pk2(kv[10], kv[11]); w1.z = pk2(kv[12], kv[13]); w1.w = pk2(kv[14], kv[15]);
        *(LAS u32x4*)(KT + ch * 72 + seg * 16) = w0; *(LAS u32x4*)(KT + ch * 72 + seg * 16 + 8) = w1;
        if (seg == 0) { const float dk = fexp(blast); dkv[ch] = dk; if (ci < 256) DK[(size_t)it * 128 + ch] = dk; }
        __syncthreads();
        const int kb = wave;
        bf16x8 a[2];
#pragma unroll
        for (int ss = 0; ss < 2; ++ss) a[ss] = *(const LAS bf16x8*)(KT + (kb * 16 + fr) * 72 + ss * 32 + fq * 8);
        const int k4 = kb * 16 + fq * 4;
        const f32x4 dk4 = *(const LAS f32x4*)(dkv + k4);
#pragma unroll
        for (int vb = 0; vb < 8; ++vb) {
            f32x4 acc = (f32x4){0.f, 0.f, 0.f, 0.f};
#pragma unroll
            for (int ss = 0; ss < 2; ++ss) { const bf16x8 b = tr_frag(VV, 136, ss * 32, vb * 16, lane); acc = __builtin_amdgcn_mfma_f32_16x16x32_bf16(a[ss], b, acc, 0, 0, 0); }
            const int v = vb * 16 + fr;
            bf16_t* ut = UT + (size_t)it * 16384 + v * 128 + k4;
            if (ci < 256) { u32x2 o; o.x = pk2(acc[0], acc[1]); o.y = pk2(acc[2], acc[3]); *(u32x2*)ut = o; }
            else { const int sb = ci - 256; const size_t sbase = ((size_t)(sb * 8 + h) * 128 + k4) * 128 + v; float s[4];
#pragma unroll
                for (int j = 0; j < 4; ++j) { s[j] = p.state_hgrn[sbase + (size_t)j * 128]; p.out[O_HS + sbase + (size_t)j * 128] = dk4[j] * s[j] + acc[j]; }
                u32x2 o; o.x = pk2(s[0], s[1]); o.y = pk2(s[2], s[3]); *(u32x2*)ut = o; }
        }
        __syncthreads();
    }
}

__device__ __forceinline__ void phase_scan(const Params& p) {
    bf16_t* UT = (bf16_t*)(p.ws + WS_S4); const float* DK = (const float*)(p.ws + M_DK);
    for (int gid = blockIdx.x * 512 + opaque_tid(); gid < 32 * 4096; gid += gridDim.x * 512) {
        const int e4 = gid & 4095, bh = gid >> 12, b = bh >> 3, h = bh & 7, v = e4 >> 5, k4 = (e4 & 31) * 4;
        f32x4 S = (f32x4){0.f, 0.f, 0.f, 0.f};
        for (int c0 = 0; c0 < 64; c0 += 8) {
            u32x2 uu[8]; f32x4 dd[8];
#pragma unroll
            for (int i = 0; i < 8; ++i) { const size_t it = (size_t)((b * 64 + c0 + i) * 8 + h); uu[i] = *(const u32x2*)(UT + it * 16384 + e4 * 4); dd[i] = *(const f32x4*)(DK + it * 128 + k4); }
#pragma unroll
            for (int i = 0; i < 8; ++i) { const size_t it = (size_t)((b * 64 + c0 + i) * 8 + h);
                u32x2 o; o.x = pk2(S[0], S[1]); o.y = pk2(S[2], S[3]); *(u32x2*)(UT + it * 16384 + e4 * 4) = o;
                S[0] = dd[i][0] * S[0] + bflo(uu[i].x); S[1] = dd[i][1] * S[1] + bfhi(uu[i].x); S[2] = dd[i][2] * S[2] + bflo(uu[i].y); S[3] = dd[i][3] * S[3] + bfhi(uu[i].y); }
        }
        float* o = p.out + O_HP + ((size_t)(b * 8 + h) * 128 + k4) * 128 + v;
#pragma unroll
        for (int j = 0; j < 4; ++j) o[(size_t)j * 128] = S[j];
    }
}

__device__ __forceinline__ void phase_O(const Params& p, LAS unsigned char* lds) {
    const int tid = opaque_tid(), wave = tid >> 6, lane = tid & 63, fr = lane & 15, fq = lane >> 4;
    LAS float* BC = (LAS float*)(lds + L_BC); LAS bf16_t* QH = (LAS bf16_t*)(lds + L_QH); LAS bf16_t* QT = (LAS bf16_t*)(lds + L_QT);
    LAS bf16_t* KH = (LAS bf16_t*)(lds + L_KH); LAS bf16_t* VV = (LAS bf16_t*)(lds + L_VV); LAS bf16_t* PP = (LAS bf16_t*)(lds + L_PP);
    LAS float* segtot = (LAS float*)(lds + L_SM); LAS float* rvec = segtot + 512; LAS float* OO = (LAS float*)(lds + L_O);
    const bf16_t* ST = (const bf16_t*)(p.ws + WS_S4);
    unsigned char* Q = (unsigned char*)p.out; const unsigned char* G = (const unsigned char*)p.out + A1;
    for (int it = blockIdx.x; it < NITEM; it += gridDim.x) {
        const int ci = it >> 3, h = it & 7, row0 = ci * 64;
        h16x8 lfv[2]; u32x4 vvv[2], qv[2], gv[2]; bf16x8 sf[4][4];
        { const unsigned char* LOGF = p.ws + WS_S1; const unsigned char* V = p.ws + WS_S2;
#pragma unroll
            for (int i = 0; i < 2; ++i) { const int v = tid + 512 * i, t = v >> 4, c8 = (v & 15) * 8; const size_t e = ((size_t)(row0 + t) * DM + h * 128 + c8) * 2;
                lfv[i] = *(const h16x8*)(LOGF + e); vvv[i] = *(const u32x4*)(V + e); qv[i] = *(const u32x4*)(Q + e); }
#pragma unroll
            for (int vi = 0; vi < 4; ++vi)
#pragma unroll
                for (int k = 0; k < 4; ++k) sf[vi][k] = *(const bf16x8*)(ST + (size_t)it * 16384 + (((wave & 1) * 4 + vi) * 16 + fr) * 128 + k * 32 + fq * 8);
            { const int t = tid >> 3, part = tid & 7; const size_t e = ((size_t)(row0 + t) * DM + h * 128 + part * 16) * 2; gv[0] = *(const u32x4*)(G + e); gv[1] = *(const u32x4*)(G + e + 16); }
#pragma unroll
            for (int i = 0; i < 2; ++i) { const int v = tid + 512 * i, t = v >> 4, c8 = (v & 15) * 8;
                *(LAS f32x4*)(BC + t * 128 + c8) = (f32x4){(float)lfv[i][0], (float)lfv[i][1], (float)lfv[i][2], (float)lfv[i][3]};
                *(LAS f32x4*)(BC + t * 128 + c8 + 4) = (f32x4){(float)lfv[i][4], (float)lfv[i][5], (float)lfv[i][6], (float)lfv[i][7]};
                *(LAS u32x4*)(VV + t * 136 + c8) = vvv[i]; } }
        __syncthreads();
        { const int ch = tid & 127, seg = tid >> 7;
            float kk[16], bl[16]; float run = 0.f;
#pragma unroll
            for (int j = 0; j < 16; ++j) { const float lf = BC[(seg * 16 + j) * 128 + ch]; kk[j] = 1.0f - fexp(lf); run += lf; bl[j] = run; }
            segtot[seg * 128 + ch] = run;
            __syncthreads();
            const float s0 = segtot[ch], s1 = segtot[128 + ch], s2 = segtot[256 + ch];
            const float r = s0 + s1;
            const float off = seg == 0 ? 0.f : seg == 1 ? s0 : seg == 2 ? s0 + s1 : s0 + s1 + s2;
#pragma unroll
            for (int j = 0; j < 16; ++j) { const float bc = off + bl[j]; const int t = seg * 16 + j; BC[t * 128 + ch] = bc;
                const float kv = kk[j] * fexp(fminf(r - bc, 80.f)); KH[t * 136 + ch] = (bf16_t)(pk2(kv, 0.f) & 0xffffu); }
            if (seg == 0) rvec[ch] = r;
        }
        __syncthreads();
#pragma unroll
        for (int i = 0; i < 2; ++i) { const int v = tid + 512 * i, t = v >> 4, c8 = (v & 15) * 8; float q[8], qh[8], qt[8];
            unpack8(qv[i], q);
#pragma unroll
            for (int j = 0; j < 8; ++j) { const float bc = BC[t * 128 + c8 + j]; qh[j] = q[j] * fexp(fmaxf(bc - rvec[c8 + j], -80.f)); qt[j] = q[j] * fexp(bc); }
            *(LAS u32x4*)(QH + t * 136 + c8) = pack8(qh); *(LAS u32x4*)(QT + t * 136 + c8) = pack8(qt); }
        __syncthreads();
        const int tb = wave >> 1;
#pragma unroll
        for (int sbi = 0; sbi < 2; ++sbi) { const int sb = (wave & 1) * 2 + sbi; f32x4 acc = (f32x4){0.f, 0.f, 0.f, 0.f};
            if (sb <= tb) {
#pragma unroll
                for (int k = 0; k < 4; ++k) { const bf16x8 a = *(const LAS bf16x8*)(QH + (tb * 16 + fr) * 136 + k * 32 + fq * 8), b = *(const LAS bf16x8*)(KH + (sb * 16 + fr) * 136 + k * 32 + fq * 8);
                    acc = __builtin_amdgcn_mfma_f32_16x16x32_bf16(b, a, acc, 0, 0, 0); }
#pragma unroll
                for (int j = 0; j < 4; ++j) acc[j] = (sb * 16 + fq * 4 + j <= tb * 16 + fr) ? acc[j] : 0.f;
            }
            u32x2 o; o.x = pk2(acc[0], acc[1]); o.y = pk2(acc[2], acc[3]); *(LAS u32x2*)(PP + (tb * 16 + fr) * 72 + sb * 16 + fq * 4) = o; }
        __syncthreads();
        { bf16x8 pa[2], qa[4];
#pragma unroll
            for (int ss = 0; ss < 2; ++ss) pa[ss] = *(const LAS bf16x8*)(PP + (tb * 16 + fr) * 72 + ss * 32 + fq * 8);
#pragma unroll
            for (int k = 0; k < 4; ++k) qa[k] = *(const LAS bf16x8*)(QT + (tb * 16 + fr) * 136 + k * 32 + fq * 8);
#pragma unroll
            for (int vi = 0; vi < 4; ++vi) { const int vb = (wave & 1) * 4 + vi; f32x4 acc = (f32x4){0.f, 0.f, 0.f, 0.f};
#pragma unroll
                for (int ss = 0; ss < 2; ++ss) { const bf16x8 vf = tr_frag(VV, 136, ss * 32, vb * 16, lane); acc = __builtin_amdgcn_mfma_f32_16x16x32_bf16(vf, pa[ss], acc, 0, 0, 0); }
#pragma unroll
                for (int k = 0; k < 4; ++k) acc = __builtin_amdgcn_mfma_f32_16x16x32_bf16(sf[vi][k], qa[k], acc, 0, 0, 0);
                *(LAS f32x4*)(OO + (tb * 16 + fr) * 132 + vb * 16 + fq * 4) = acc; }
        }
        __syncthreads();
        { const int t = tid >> 3, part = tid & 7; float o[16]; float ss = 0.f;
#pragma unroll
            for (int j = 0; j < 4; ++j) { const f32x4 x = *(const LAS f32x4*)(OO + t * 132 + part * 16 + 4 * j); o[4 * j] = x[0]; o[4 * j + 1] = x[1]; o[4 * j + 2] = x[2]; o[4 * j + 3] = x[3]; ss += (x[0] * x[0] + x[1] * x[1]) + (x[2] * x[2] + x[3] * x[3]); }
            ss += __shfl_xor(ss, 1); ss += __shfl_xor(ss, 2); ss += __shfl_xor(ss, 4);
            const float rstd = rsqrtf(ss * (1.0f / 128.f) + EPS);
            const size_t e = ((size_t)(row0 + t) * DM + h * 128 + part * 16) * 2;
#pragma unroll
            for (int hh = 0; hh < 2; ++hh) { float g[8], y[8]; unpack8(gv[hh], g);
#pragma unroll
                for (int j = 0; j < 8; ++j) y[j] = o[hh * 8 + j] * rstd * p.hg_norm[part * 16 + hh * 8 + j] * g[j];
                *(u32x4*)(Q + e + hh * 16) = pack8(y); }
        }
        __syncthreads();
    }
}

__device__ __forceinline__ void phase_final(const Params& p) {
    const int tid_ = opaque_tid(); const int wave = tid_ >> 6, lane = tid_ & 63; const float* rss3 = (const float*)(p.ws + M_RSS) + 3 * MT;
    for (int row = blockIdx.x * 8 + wave; row < MT; row += gridDim.x * 8) {
        const float rs = rsqrtf(rss3[row] * (1.0f / DM) + EPS); float* y = p.out + (size_t)row * DM;
#pragma unroll
        for (int j = 0; j < 4; ++j) { f32x4 v = *(f32x4*)(y + 4 * lane + 256 * j); const f32x4 g = *(const f32x4*)(p.norm_final + 4 * lane + 256 * j);
            v[0] *= rs * g[0]; v[1] *= rs * g[1]; v[2] *= rs * g[2]; v[3] *= rs * g[3]; *(f32x4*)(y + 4 * lane + 256 * j) = v; }
    }
}

#define XB_TMO      128
#define XB_XCNT(j)  (256  + 64 * (j))
#define XB_XSUB(j)  (1280 + 64 * (j))
#define XB_XGEN(j)  (2304 + 64 * (j))
#define XB_TOP      3328
#define XB_TOPGEN   3392
#define XCD_BAR_WORDS 3456
#define XB_SPIN_CAP (1u << 18)
__device__ __forceinline__ unsigned xb_ld(unsigned* p)              { return __hip_atomic_load(p, __ATOMIC_RELAXED, __HIP_MEMORY_SCOPE_AGENT); }
__device__ __forceinline__ unsigned xb_add(unsigned* p, unsigned v) { return __hip_atomic_fetch_add(p, v, __ATOMIC_RELAXED, __HIP_MEMORY_SCOPE_AGENT); }
__device__ __forceinline__ unsigned xb_xcc_id() { return (unsigned)__builtin_amdgcn_s_getreg((3 << 11) | 20) & 0xFu; }
#define XB_SPIN(cond, bar) do { unsigned _sp = 0; while (cond) { __builtin_amdgcn_s_sleep(1); \
    if ((++_sp & 255u) == 0u) { if (xb_ld(&(bar)[XB_TMO])) break; if (_sp > XB_SPIN_CAP) { atomicAdd(&(bar)[XB_TMO], 1u); break; } } } } while (0)
struct XcdBarrier { unsigned* bar; unsigned x; volatile LAS unsigned* st; };
__device__ __forceinline__ XcdBarrier xcd_barrier_post(unsigned* bar, volatile LAS unsigned* st) {
    XcdBarrier b; b.bar = bar; b.x = xb_xcc_id(); b.st = st;
    if (threadIdx.x == 0) st[3] = xb_add(&bar[XB_XCNT(b.x)], 1u);
    return b;
}
__device__ __forceinline__ void xcd_barrier_complete(unsigned* bar, unsigned x, unsigned& nloc, unsigned& nx) {
    const unsigned G = gridDim.x * gridDim.y * gridDim.z;
    unsigned sum, cnt, mine, sp = 0u;
    for (;;) {
        sum = 0u; cnt = 0u; mine = 0u;
#pragma unroll
        for (unsigned j = 0; j < 16; ++j) { const unsigned c = xb_ld(&bar[XB_XCNT(j)]); sum += c; cnt += (c > 0u) ? 1u : 0u; mine = (j == x) ? c : mine; }
        if (sum == G) break;
        __builtin_amdgcn_s_sleep(1);
        if ((++sp & 255u) == 0u) { if (xb_ld(&bar[XB_TMO])) break; if (sp > XB_SPIN_CAP) { atomicAdd(&bar[XB_TMO], 1u); break; } }
    }
    nloc = mine > 0u ? mine : 1u; nx = cnt > 0u ? cnt : 1u;
}
__device__ __forceinline__ void xcd_barrier(const XcdBarrier& b) {
    asm volatile("s_waitcnt vmcnt(0)" ::: "memory");
    __syncthreads();
    if (threadIdx.x == 0) {
        unsigned* bar = b.bar;
        __builtin_amdgcn_s_waitcnt(0);
        unsigned nloc = b.st[0], nx = b.st[1];
        if (nloc == 0u) { xcd_barrier_complete(bar, b.x, nloc, nx); b.st[0] = nloc; b.st[1] = nx; }
        const unsigned old = xb_add(&bar[XB_XSUB(b.x)], 1u);
        const unsigned gen = old / nloc;
        if (old + 1u == (gen + 1u) * nloc) {
            __builtin_amdgcn_fence(__ATOMIC_RELEASE, "agent");
            asm volatile("s_waitcnt vmcnt(0)" ::: "memory");
            const unsigned og = xb_add(&bar[XB_TOP], 1u);
            const unsigned tg = og / nx;
            if (og + 1u == (tg + 1u) * nx) xb_add(&bar[XB_TOPGEN], 1u);
            else XB_SPIN(xb_ld(&bar[XB_TOPGEN]) == tg, bar);
            __builtin_amdgcn_fence(__ATOMIC_ACQUIRE, "agent");
            xb_add(&bar[XB_XGEN(b.x)], 1u);
            asm volatile("s_waitcnt vmcnt(0)" ::: "memory");
        } else {
            XB_SPIN(xb_ld(&bar[XB_XGEN(b.x)]) == gen, bar);
            __builtin_amdgcn_fence(__ATOMIC_ACQUIRE, "agent");
            asm volatile("s_waitcnt vmcnt(0)" ::: "memory");
        }
    }
    __syncthreads();
}

__global__ void __launch_bounds__(512, 2) hgrn2_shortconv_fwd(Params p) {
    extern __shared__ __attribute__((aligned(16))) unsigned char smem[];
    LAS unsigned char* lds = (LAS unsigned char*)smem;
    cg::grid_group grid = cg::this_grid();
    unsigned char* ws = p.ws; unsigned char* outb = (unsigned char*)p.out;
    const int G = gridDim.x, c = blockIdx.x;
    unsigned* cnt = (unsigned*)(ws + M_CNT);

    volatile LAS unsigned* xbw = (volatile LAS unsigned*)(lds + LDS_BYTES - 16);
    if (threadIdx.x == 0) { xbw[0] = 0u; xbw[1] = 0u; xbw[2] = 0u; xbw[3] = 0u; }
    __syncthreads();
    const XcdBarrier xb = xcd_barrier_post((unsigned*)(ws + M_BAR), xbw);
    if (p.ws == nullptr) grid.sync();
#define RUN_STREAM(mode_, lo_, hi_) do { Stream S{ws, outb, mode_, G, (lo_) + c, hi_, 0, 0}; gemm_stream(lds, S, p); } while (0)
    phase_prep(p, lds);
    xcd_barrier(xb);
    int c8 = c, cx = c;
    { unsigned* bar = (unsigned*)(ws + M_BAR); bool ok = (G == 256);
#pragma unroll
        for (int j = 0; j < 16; ++j) { const unsigned n = xb_ld(&bar[XB_XCNT(j)]); ok = ok && (n == (j < 8 ? 32u : 0u)); }
        const unsigned rank = xbw[3], xcc = xb.x;
        if (ok && rank < 32u && xcc < 8u) { c8 = (int)(rank * 8u + xcc); cx = (int)(xcc * 32u + rank); } }
    { Stream S{ws, outb, 0, G, c8, 1904, 0, 0}; gemm_stream(lds, S, p); }
    { const int lo = G > 112 ? 112 : 0; if (c8 >= lo) prep_items(p, lds, PREP_I_IN, PREP_NIT, (c8 - lo) * 8 + (opaque_tid() >> 6), (G - lo) * 8); }
    xcd_barrier(xb);
    phase_conv(p);
    xcd_barrier(xb);
    phase_U(p, lds);
    xcd_barrier(xb);
    phase_scan(p);
    xcd_barrier(xb);
    phase_O(p, lds);
    xcd_barrier(xb);
    { Stream S{ws, outb, 1, G, cx, 560, 0, 0}; gemm_stream(lds, S, p); }
    { Stream S{ws, outb, 1, G, 544 + ((cx + 128) & 255), 1088, 0, 0}; gemm_stream(lds, S, p); }
    xcd_barrier(xb);
    phase_pconv(p, cnt);
    { Stream S{ws, outb, 2, G, cx, 2312, 0, 0}; gemm_stream(lds, S, p); }
    xcd_barrier(xb);
    phase_final(p);
}

extern "C" void kernel_launch(void* const* d_in, const int* in_sizes, int n_in, void* d_out, int out_size, void* d_ws, size_t ws_size, hipStream_t stream) {
    static int grid_blocks = 0;
    if (grid_blocks == 0) {
        if (n_in != 21 || ws_size < WS_NEED) { fprintf(stderr, "kernel_launch: unexpected n_in %d / ws_size %zu (need %zu)\n", n_in, ws_size, (size_t)WS_NEED); grid_blocks = -1; return; }
        int dev = 0, cus = 0, per_cu = 0;
        hipGetDevice(&dev);
        hipDeviceGetAttribute(&cus, hipDeviceAttributeMultiprocessorCount, dev);
        if (hipFuncSetAttribute((const void*)hgrn2_shortconv_fwd, hipFuncAttributeMaxDynamicSharedMemorySize, LDS_BYTES) != hipSuccess) { fprintf(stderr, "kernel_launch: hipFuncSetAttribute failed\n"); grid_blocks = -1; return; }
        if (hipOccupancyMaxActiveBlocksPerMultiprocessor(&per_cu, (const void*)hgrn2_shortconv_fwd, 512, LDS_BYTES) != hipSuccess || per_cu < 1) { fprintf(stderr, "kernel_launch: occupancy query gave %d\n", per_cu); per_cu = 1; }
        (void)hipGetLastError();
        grid_blocks = cus * per_cu;
    }
    if (grid_blocks < 0) return;
    if (hipMemsetAsync((unsigned char*)d_ws + M_BAR, 0, CTL_BYTES, stream) != hipSuccess) { fprintf(stderr, "kernel_launch: memset failed\n"); return; }
    Params p{};
    const float** f = (const float**)&p;
    for (int i = 0; i < 21; ++i) f[i] = (const float*)d_in[i];
    p.out = (float*)d_out; p.ws = (unsigned char*)d_ws;
    void* args[] = {&p};
    hipError_t e = hipLaunchCooperativeKernel((const void*)hgrn2_shortconv_fwd, dim3(grid_blocks), dim3(512), args, LDS_BYTES, stream);
    if (e != hipSuccess) fprintf(stderr, "cooperative launch failed: %s (grid %d)\n", hipGetErrorString(e), grid_blocks);
}
```
